# Optimizing an MI355X kernel written in HIP

```python
import math
import jax, jax.numpy as jnp
from jax import lax
import numpy as np

D_MODEL = 1024
BATCH = 8
SEQ = 4096
DEPTH = 1

PLE_DIM = 256
D_FF = 2816
EPS = 1e-6
ATT_HEADS = 8
ATT_HEAD_DIM = 64
KV_LATENT = 128
IDX_HEADS = 8
IDX_HEAD_DIM = 64
TOPK_MAX = 256
Q_BLOCK = 128
ATT_SCALE = ATT_HEAD_DIM ** -0.5
IDX_W_SCALE = (IDX_HEADS ** -0.5) * (IDX_HEAD_DIM ** -0.5)
REL_BUCKETS = 32
REL_MAX_DIST = 128
HG_HEADS = 4
HG_KEY_DIM = 128
HG_VAL_DIM = 128
CHUNK = 64
ATT_WIDTH = ATT_HEADS * ATT_HEAD_DIM
IDX_Q_WIDTH = IDX_HEADS * IDX_HEAD_DIM
HG_KW = HG_HEADS * HG_KEY_DIM
HG_VW = HG_HEADS * HG_VAL_DIM
IN_SPLITS = (ATT_WIDTH, KV_LATENT, IDX_Q_WIDTH, IDX_HEAD_DIM, IDX_HEADS, HG_KW, HG_KW, HG_VW, HG_VW, D_MODEL, D_MODEL)
N_IN = sum(IN_SPLITS)

kernel_name = 'hybrid_dsa_hgrn2_macaron'


def rms_norm(x, g):
    xf = x.astype(jnp.float32)
    y = xf * lax.rsqrt(jnp.mean(xf * xf, axis=-1, keepdims=True) + EPS)
    return (y * g.astype(jnp.float32)).astype(x.dtype)


def swiglu(x, w_gate, w_up, w_down):
    return (jax.nn.silu(x @ w_gate) * (x @ w_up)) @ w_down


def split_cols(a):
    outs = []
    off = 0
    for w in IN_SPLITS:
        outs.append(a[..., off:off + w])
        off += w
    return outs


def rel_bucket(dist):
    max_exact = REL_BUCKETS // 2
    d_f = jnp.maximum(dist, 1).astype(jnp.float32)
    log_b = max_exact + (jnp.log(d_f / max_exact) / math.log(REL_MAX_DIST / max_exact)
                         * (REL_BUCKETS - max_exact)).astype(jnp.int32)
    return jnp.where(dist < max_exact, dist, jnp.minimum(log_b, REL_BUCKETS - 1))


def dsa_branch(q, c_kv, q_idx, k_idx, w_idx, w_uk, w_uv, rel_bias):
    B_, S_ = q.shape[0], q.shape[1]
    topk = min(TOPK_MAX, S_ // 4)
    nblk = S_ // Q_BLOCK
    q_lat = jnp.einsum('bshd,hcd->bshc', q, w_uk)
    key_pos = jnp.arange(S_, dtype=jnp.int32)

    def to_blocks(a):
        return jnp.moveaxis(a.reshape((B_, nblk, Q_BLOCK) + a.shape[2:]), 1, 0)

    def block(args):
        ql, qi, wi, t_pos = args
        dots = jnp.einsum('bqhd,bsd->bqhs', qi, k_idx)
        score = jnp.einsum('bqh,bqhs->bqs', wi, jax.nn.relu(dots)).astype(jnp.float32)
        causal = key_pos[None, :] <= t_pos[:, None]
        score = jnp.where(causal[None], score, -jnp.inf)
        _, idx = lax.top_k(score, topk)
        valid = idx <= t_pos[None, :, None]
        c_sel = jax.vmap(lambda c, i: c[i])(c_kv, idx)
        dist = jnp.maximum(t_pos[None, :, None] - idx, 0)
        bias = jnp.moveaxis(rel_bias[rel_bucket(dist)], -1, 2)
        logits = (jnp.einsum('bqhc,bqkc->bqhk', ql.astype(jnp.float32), c_sel.astype(jnp.float32)) * ATT_SCALE
                  + bias.astype(jnp.float32))
        logits = jnp.where(valid[:, :, None, :], logits, -jnp.inf)
        probs = jax.nn.softmax(logits, axis=-1).astype(c_kv.dtype)
        return jnp.einsum('bqhk,bqkc->bqhc', probs, c_sel)

    t_blocks = jnp.arange(S_, dtype=jnp.int32).reshape(nblk, Q_BLOCK)
    o_lat = lax.map(block, (to_blocks(q_lat), to_blocks(q_idx), to_blocks(w_idx), t_blocks))
    o_lat = jnp.moveaxis(o_lat, 0, 1).reshape(B_, S_, ATT_HEADS, KV_LATENT)
    o = jnp.einsum('bshc,hcd->bshd', o_lat, w_uv)
    return o.reshape(B_, S_, ATT_WIDTH)


def hgrn2_chunkwise(q, k, v, log_f):
    B_, S_, H_, DK_ = q.shape
    DV_ = v.shape[-1]
    n = S_ // CHUNK

    def chunks(a):
        return jnp.moveaxis(a.astype(jnp.float32).reshape(B_, n, CHUNK, H_, a.shape[-1]), 1, 0)

    tri = jnp.tril(jnp.ones((CHUNK, CHUNK), dtype=bool))

    def step(state, inp):
        qc, kc, vc, gc = inp
        G = jnp.cumsum(gc, axis=1)
        o_inter = jnp.einsum('bthk,bhkv->bthv', qc * jnp.exp(G), state)
        diff = G[:, :, None] - G[:, None, :]
        decay = jnp.exp(jnp.where(tri[None, :, :, None, None], diff, -jnp.inf))
        A = jnp.einsum('bthk,bshk,btshk->bhts', qc, kc, decay)
        o_intra = jnp.einsum('bhts,bshv->bthv', A, vc)
        G_last = G[:, -1]
        k_dec = kc * jnp.exp(G_last[:, None] - G)
        new_state = jnp.exp(G_last)[..., None] * state + jnp.einsum('bshk,bshv->bhkv', k_dec, vc)
        return new_state, o_inter + o_intra

    s0 = jnp.zeros((B_, H_, DK_, DV_), jnp.float32)
    _, o = lax.scan(step, s0, (chunks(q), chunks(k), chunks(v), chunks(log_f)))
    return jnp.moveaxis(o, 0, 1).reshape(B_, S_, H_, DV_)


def setup_inputs(seed: int = 0) -> dict:
    key = jax.random.key(seed)
    ks = jax.random.split(key, 40)

    def nrm(k, shape, scale):
        return jax.random.normal(k, shape, jnp.float32) * scale

    def gain(k, shape):
        return 1.0 + 0.05 * jax.random.normal(k, shape, jnp.float32)

    L = DEPTH
    D = D_MODEL
    return {
        'x': nrm(ks[0], (BATCH, SEQ, D), 1.0),
        'p': nrm(ks[1], (DEPTH, BATCH, SEQ, PLE_DIM), 1.0),
        'rel_bias': nrm(ks[2], (REL_BUCKETS, ATT_HEADS), 0.1),
        'hgrn_lb': nrm(ks[3], (DEPTH + 1, HG_KW), 1.0),
        'ffn1_pre_g': gain(ks[4], (L, D)),
        'ffn1_post_g': gain(ks[5], (L, D)),
        'ffn1_w_gate': nrm(ks[6], (L, D, D_FF), D ** -0.5),
        'ffn1_w_up': nrm(ks[7], (L, D, D_FF), D ** -0.5),
        'ffn1_w_down': nrm(ks[8], (L, D_FF, D), D_FF ** -0.5),
        'mix_pre_g': gain(ks[9], (L, D)),
        'mix_post_g': gain(ks[10], (L, D)),
        'w_in': nrm(ks[11], (L, D, N_IN), D ** -0.5),
        'kv_norm_g': gain(ks[12], (L, KV_LATENT)),
        'kidx_norm_g': gain(ks[13], (L, IDX_HEAD_DIM)),
        'w_uk': nrm(ks[14], (L, ATT_HEADS, KV_LATENT, ATT_HEAD_DIM), KV_LATENT ** -0.5),
        'w_uv': nrm(ks[15], (L, ATT_HEADS, KV_LATENT, ATT_HEAD_DIM), KV_LATENT ** -0.5),
        'hgrn_norm_g': gain(ks[16], (L, HG_VAL_DIM)),
        'w_br_a': nrm(ks[17], (L, ATT_WIDTH, D), ATT_WIDTH ** -0.5),
        'w_br_b': nrm(ks[18], (L, HG_VW, D), HG_VW ** -0.5),
        'b_gate': nrm(ks[19], (L, 2 * D), 0.02),
        'w_out': nrm(ks[20], (L, D, D), D ** -0.5),
        'ffn2_pre_g': gain(ks[21], (L, D)),
        'ffn2_post_g': gain(ks[22], (L, D)),
        'ffn2_w_gate': nrm(ks[23], (L, D, D_FF), D ** -0.5),
        'ffn2_w_up': nrm(ks[24], (L, D, D_FF), D ** -0.5),
        'ffn2_w_down': nrm(ks[25], (L, D_FF, D), D_FF ** -0.5),
        'ple_pre_g': gain(ks[26], (L, D)),
        'ple_post_g': gain(ks[27], (L, D)),
        'w_ple_gate': nrm(ks[28], (L, D, D), D ** -0.5),
        'w_ple_proj': nrm(ks[29], (L, PLE_DIM, D), PLE_DIM ** -0.5),
    }


def reference(x, p, rel_bias, hgrn_lb, ffn1_pre_g, ffn1_post_g, ffn1_w_gate, ffn1_w_up, ffn1_w_down,
              mix_pre_g, mix_post_g, w_in, kv_norm_g, kidx_norm_g, w_uk, w_uv, hgrn_norm_g,
              w_br_a, w_br_b, b_gate, w_out, ffn2_pre_g, ffn2_post_g, ffn2_w_gate, ffn2_w_up, ffn2_w_down,
              ple_pre_g, ple_post_g, w_ple_gate, w_ple_proj):
    B_, S_, D = x.shape
    lower_bounds = jnp.cumsum(jax.nn.softmax(hgrn_lb.astype(jnp.float32), axis=0), axis=0)
    h = x
    for i in range(DEPTH):
        h = h + 0.5 * rms_norm(swiglu(rms_norm(h, ffn1_pre_g[i]), ffn1_w_gate[i], ffn1_w_up[i], ffn1_w_down[i]),
                               ffn1_post_g[i])
        u = rms_norm(h, mix_pre_g[i])
        proj = u @ w_in[i]
        (q_a, c_kv, q_idx, k_idx, w_idx, q_h, f_h, i_h, g_h, gate_a, gate_b) = split_cols(proj)
        c_kv = rms_norm(c_kv, kv_norm_g[i])
        k_idx = rms_norm(k_idx, kidx_norm_g[i])
        y_a = dsa_branch(q_a.reshape(B_, S_, ATT_HEADS, ATT_HEAD_DIM), c_kv,
                         q_idx.reshape(B_, S_, IDX_HEADS, IDX_HEAD_DIM), k_idx, w_idx * IDX_W_SCALE,
                         w_uk[i], w_uv[i], rel_bias)
        lb = lower_bounds[i]
        f = (lb + (1.0 - lb) * jax.nn.sigmoid(f_h.astype(jnp.float32))).reshape(B_, S_, HG_HEADS, HG_KEY_DIM)
        o_h = hgrn2_chunkwise(jax.nn.silu(q_h).reshape(B_, S_, HG_HEADS, HG_KEY_DIM), 1.0 - f,
                              i_h.reshape(B_, S_, HG_HEADS, HG_VAL_DIM), jnp.log(f))
        o_h = rms_norm(o_h, hgrn_norm_g[i]) * jax.nn.silu(g_h.astype(jnp.float32).reshape(B_, S_, HG_HEADS, HG_VAL_DIM))
        y_b = o_h.reshape(B_, S_, HG_VW).astype(x.dtype)
        merged = (jax.nn.sigmoid(gate_a + b_gate[i, :D]) * (y_a @ w_br_a[i])
                  + jax.nn.sigmoid(gate_b + b_gate[i, D:]) * (y_b @ w_br_b[i]))
        h = h + rms_norm(merged @ w_out[i], mix_post_g[i])
        h = h + 0.5 * rms_norm(swiglu(rms_norm(h, ffn2_pre_g[i]), ffn2_w_gate[i], ffn2_w_up[i], ffn2_w_down[i]),
                               ffn2_post_g[i])
        ple_gate = jax.nn.sigmoid(rms_norm(h, ple_pre_g[i]) @ w_ple_gate[i])
        h = h + rms_norm(ple_gate * (p[i] @ w_ple_proj[i]), ple_post_g[i])
    return h
```

```cpp
#include <hip/hip_runtime.h>
#include <cstdio>
#include <cstdint>

#ifndef MK_PER_PHASE_LAUNCH
#define MK_PER_PHASE_LAUNCH 0
#endif

#define LAS __attribute__((address_space(3)))
#define GAS __attribute__((address_space(1)))
typedef _Float16 f16;
typedef _Float16 f16x2 __attribute__((ext_vector_type(2)));
typedef _Float16 f16x4 __attribute__((ext_vector_type(4)));
typedef _Float16 f16x8 __attribute__((ext_vector_type(8)));
typedef float f32x2 __attribute__((ext_vector_type(2)));
typedef float f32x4 __attribute__((ext_vector_type(4)));
typedef unsigned u32x4 __attribute__((ext_vector_type(4)));

constexpr int BATCH = 8, SEQ = 4096, DM = 1024, FF = 2816, M = BATCH * SEQ, PLE = 256;
constexpr int NIN = 3840;
constexpr int NGATE = 2048;
constexpr float EPS = 1e-6f;
constexpr int NWAVES = 8, NTHREADS = 512;
constexpr int NPHASE = 19;

constexpr size_t MiB = 1u << 20;
constexpr size_t WS_CTL = 0, CTL_ZERO_BYTES = 1 * MiB;
constexpr size_t WS_W = 1 * MiB;
constexpr size_t W_GU1 = WS_W, W_D1 = W_GU1 + 11 * MiB, W_IN = W_D1 + 11 * MiB / 2, W_G = W_IN + 15 * MiB / 2, W_BRB = W_G + 4 * MiB,
                 W_UVBR = W_BRB + 1 * MiB, W_OUT = W_UVBR + 2 * MiB, W_GU2 = W_OUT + 2 * MiB, W_D2 = W_GU2 + 11 * MiB, W_PG = W_D2 + 11 * MiB / 2,
                 W_PP = W_PG + 2 * MiB, W_LB = W_PP + MiB / 2;
static_assert(W_LB + 4096 <= 54 * MiB, "weights region");
constexpr size_t WS_XN = 54 * MiB, WS_Y = 118 * MiB, WS_OH = 118 * MiB, WS_YB = 150 * MiB, WS_ACT = 182 * MiB;
constexpr size_t WS_QLAT = 182 * MiB, WS_QIDX = 246 * MiB, WS_QH = 278 * MiB, WS_IH = 310 * MiB, WS_GH = 342 * MiB, WS_LOGF = 374 * MiB,
                 WS_SMALL = 438 * MiB, WS_CKV = 470 * MiB, WS_KIDX = 478 * MiB, WS_WQ = 482 * MiB, WS_P16 = 483 * MiB;
constexpr size_t WS_G = 246 * MiB, WS_MERGED = 374 * MiB, WS_GP = 358 * MiB, WS_END = 512 * MiB;
constexpr int CW_BAR = 4096;

constexpr int RING_BYTES = 131072, WSM_OFF = 131072, WSM_BYTES = 2560, TAB_OFF = WSM_OFF + 8 * WSM_BYTES, LDSCTL_OFF = TAB_OFF + 3072, LDS_BYTES = 160 * 1024;
static_assert(LDSCTL_OFF + 512 <= LDS_BYTES, "LDS map");

struct Args { const float* in[30]; float* out; unsigned char* ws; int ph_lo, ph_hi; };

__device__ __forceinline__ float wave_sum(float v) {
#pragma unroll
    for (int o = 1; o < 64; o <<= 1) v += __shfl_xor(v, o);
    return v;
}
__device__ __forceinline__ float wave_max(float v) {
#pragma unroll
    for (int o = 1; o < 64; o <<= 1) v = fmaxf(v, __shfl_xor(v, o));
    return v;
}
__device__ __forceinline__ float sigmoidf_(float x) { return __builtin_amdgcn_rcpf(1.0f + __expf(-x)); }
__device__ __forceinline__ float siluf_(float x) { return x * sigmoidf_(x); }
__device__ __forceinline__ float dot8(f16x8 a, f16x8 b, float c) {
    c = __builtin_amdgcn_fdot2(__builtin_shufflevector(a, a, 0, 1), __builtin_shufflevector(b, b, 0, 1), c, false);
    c = __builtin_amdgcn_fdot2(__builtin_shufflevector(a, a, 2, 3), __builtin_shufflevector(b, b, 2, 3), c, false);
    c = __builtin_amdgcn_fdot2(__builtin_shufflevector(a, a, 4, 5), __builtin_shufflevector(b, b, 4, 5), c, false);
    c = __builtin_amdgcn_fdot2(__builtin_shufflevector(a, a, 6, 7), __builtin_shufflevector(b, b, 6, 7), c, false);
    return c;
}

typedef short bf16x8 __attribute__((ext_vector_type(8)));
typedef short s16x4 __attribute__((ext_vector_type(4)));
typedef __bf16 bf16x2_t __attribute__((ext_vector_type(2)));
__device__ __forceinline__ unsigned pk_bf16(float lo, float hi) { f32x2 v = {lo, hi}; bf16x2_t b = __builtin_convertvector(v, bf16x2_t); return __builtin_bit_cast(unsigned, b); }
__device__ __forceinline__ s16x4 lds_tr16(const LAS unsigned char* p) { return __builtin_bit_cast(s16x4, __builtin_amdgcn_ds_read_tr16_b64_v4i16((LAS s16x4*)p)); }
__device__ __forceinline__ bf16x8 cat44(s16x4 a, s16x4 b) { return __builtin_shufflevector(a, b, 0, 1, 2, 3, 4, 5, 6, 7); }
__device__ __forceinline__ bf16x8 pack_bf8(f32x4 a, f32x4 b) { u32x4 w; w[0] = pk_bf16(a[0], a[1]); w[1] = pk_bf16(a[2], a[3]); w[2] = pk_bf16(b[0], b[1]); w[3] = pk_bf16(b[2], b[3]); return __builtin_bit_cast(bf16x8, w); }
__device__ __forceinline__ unsigned off_b(unsigned row, unsigned ch) { return 256u * row + 16u * (ch ^ (((row & 3u) << 2) | ((row >> 2) & 3u))); }

__device__ __forceinline__ int wave_total_i(int v) {
    v += __builtin_amdgcn_mov_dpp(v, 0xB1, 0xF, 0xF, true);
    v += __builtin_amdgcn_mov_dpp(v, 0x4E, 0xF, 0xF, true);
    v += __builtin_amdgcn_mov_dpp(v, 0x141, 0xF, 0xF, true);
    v += __builtin_amdgcn_mov_dpp(v, 0x140, 0xF, 0xF, true);
    return __builtin_amdgcn_readlane(v, 0) + __builtin_amdgcn_readlane(v, 16) + __builtin_amdgcn_readlane(v, 32) + __builtin_amdgcn_readlane(v, 48);
}
#define LDS_WAIT() asm volatile("s_waitcnt lgkmcnt(0)" ::: "memory")
#define VM_WAIT() asm volatile("s_waitcnt vmcnt(0)" ::: "memory")

namespace pg8 {
constexpr int BM = 256, BK = 64, HALF = 128, HTB = HALF * BK * 2, STAGE_BYTES = 8 * HTB, NXCD = 8, WGM = 8;
__host__ __device__ __forceinline__ int lds_byte(int r, int c) { const int st = (r >> 4) * 2 + (c >> 5), rr = r & 15, cc = c & 31, ob = rr * 64 + cc * 2; return st * 1024 + (ob ^ (((ob >> 9) & 1) << 5)); }
__host__ __device__ __forceinline__ void stage_rc(int b, int& R, int& C) { const int st = b / 1024, sb = b % 1024, swz = sb ^ (((sb >> 9) & 1) << 5); R = (st >> 1) * 16 + swz / 64; C = (st & 1) * 32 + (swz % 64) / 2; }
__host__ __device__ __forceinline__ int perm32(int rho) { const int n = rho >> 4, i = rho & 15; return 8 * (i >> 2) + 4 * n + (i & 3); }
struct Unit { int pm, pn; };
struct Gemm { const f16* A; const f16* Bt; int M, N, K; };
struct StaticOrder {
    int nM, nN, nwg, G, c;
    __device__ void init(int M_, int N_, int G_, int c_) { nM = M_ / BM; nN = N_ / BM; nwg = nM * nN; G = G_; c = c_; }
    __device__ bool next(int i, Unit& u) const {
        const long L = (long)i * G + c; if (L >= nwg) return false;
        int wgid = (int)L; { const int q = nwg / NXCD, r = nwg % NXCD, xcd = wgid % NXCD, off = wgid / NXCD; wgid = (xcd < r ? xcd * (q + 1) : r * (q + 1) + (xcd - r) * q) + off; }
        const int nig = WGM * nN, gid = wgid / nig, fm = gid * WGM, gsz = (nM - fm) < WGM ? (nM - fm) : WGM;
        u.pm = fm + ((wgid % nig) % gsz); u.pn = (wgid % nig) / gsz; return true;
    }
};

enum { EP_SWIGLU = 0, EP_F16 = 1, EP_INPROJ = 2, EP_GATES = 3, EP_BRA = 4, EP_BRB = 5, EP_PLE1 = 6, EP_PLE2 = 7 };
__device__ __forceinline__ f16x8 pack8(f32x4 a, f32x4 b) { f16x8 w; w[0] = (f16)a[0]; w[1] = (f16)a[1]; w[2] = (f16)a[2]; w[3] = (f16)a[3]; w[4] = (f16)b[0]; w[5] = (f16)b[1]; w[6] = (f16)b[2]; w[7] = (f16)b[3]; return w; }
template <int MODE> struct Epi {
    f16* O; int ldc; const f16* Gt; const float* bias;
    f16 *qlat, *qidx, *qh, *ih, *gh; float *logf, *small; const float* lb;
    __device__ __forceinline__ void operator()(const f32x4 (&acc)[2][2][4][2], const Unit& u, int wr, int wc, int fr, int fq) const {
        const int row0 = u.pm * BM + wr * 64 + fr;
        if constexpr (MODE == EP_SWIGLU) {
            const int col = u.pn * 128 + wc * 32 + 8 * fq;
#pragma unroll
            for (int ai = 0; ai < 2; ++ai)
#pragma unroll
                for (int m = 0; m < 4; ++m) { const size_t row = row0 + ai * HALF + m * 16; f32x4 v[2];
#pragma unroll
                    for (int n = 0; n < 2; ++n)
#pragma unroll
                        for (int j = 0; j < 4; ++j) v[n][j] = siluf_(acc[ai][0][m][n][j]) * acc[ai][1][m][n][j];
                    *(f16x8*)(O + row * ldc + col) = pack8(v[0], v[1]); }
        } else {
            const int colb = u.pn * BM + wc * 32 + 8 * fq;
            f32x4 bv[2][2] = {{{0.f, 0.f, 0.f, 0.f}, {0.f, 0.f, 0.f, 0.f}}, {{0.f, 0.f, 0.f, 0.f}, {0.f, 0.f, 0.f, 0.f}}};
            if constexpr (MODE == EP_GATES) {
#pragma unroll
                for (int bj = 0; bj < 2; ++bj) { bv[bj][0] = *(const f32x4*)(bias + colb + bj * HALF); bv[bj][1] = *(const f32x4*)(bias + colb + bj * HALF + 4); } }
            if constexpr (MODE == EP_INPROJ) { if (u.pn == 8 || u.pn == 9) {
#pragma unroll
                for (int bj = 0; bj < 2; ++bj) { bv[bj][0] = *(const f32x4*)(lb + colb + bj * HALF - 2048); bv[bj][1] = *(const f32x4*)(lb + colb + bj * HALF - 2048 + 4); } } }
#pragma unroll
            for (int ai = 0; ai < 2; ++ai)
#pragma unroll
                for (int m = 0; m < 4; ++m) { const size_t row = row0 + ai * HALF + m * 16;
#pragma unroll
                    for (int bj = 0; bj < 2; ++bj) { const int col = colb + bj * HALF; f32x4 v0 = acc[ai][bj][m][0], v1 = acc[ai][bj][m][1];
                        if constexpr (MODE == EP_F16) { *(f16x8*)(O + row * ldc + col) = pack8(v0, v1); }
                        if constexpr (MODE == EP_GATES || MODE == EP_PLE1) {
#pragma unroll
                            for (int j = 0; j < 4; ++j) { v0[j] = sigmoidf_(v0[j] + bv[bj][0][j]); v1[j] = sigmoidf_(v1[j] + bv[bj][1][j]); }
                            *(f16x8*)(O + row * ldc + col) = pack8(v0, v1); }
                        if constexpr (MODE == EP_BRA || MODE == EP_BRB || MODE == EP_PLE2) {
                            const f16x8 g = *(const f16x8*)(Gt + row * (MODE == EP_PLE2 ? 1024 : 2048) + (MODE == EP_BRB ? 1024 : 0) + col);
#pragma unroll
                            for (int j = 0; j < 4; ++j) { v0[j] *= (float)g[j]; v1[j] *= (float)g[4 + j]; }
                            if constexpr (MODE == EP_BRB) { const f16x8 o = *(const f16x8*)(O + row * ldc + col);
#pragma unroll
                                for (int j = 0; j < 4; ++j) { v0[j] += (float)o[j]; v1[j] += (float)o[4 + j]; } }
                            *(f16x8*)(O + row * ldc + col) = pack8(v0, v1); }
                        if constexpr (MODE == EP_INPROJ) {
                            const int pn = u.pn;
                            if (pn < 4) { *(f16x8*)(qlat + row * 1024 + col) = pack8(v0, v1); }
                            else if (pn < 6) { *(f16x8*)(qidx + row * 512 + (col - 1024)) = pack8(v0, v1); }
                            else if (pn < 8) {
#pragma unroll
                                for (int j = 0; j < 4; ++j) { v0[j] = siluf_(v0[j]); v1[j] = siluf_(v1[j]); }
                                *(f16x8*)(qh + row * 512 + (col - 1536)) = pack8(v0, v1); }
                            else if (pn < 10) {
#pragma unroll
                                for (int j = 0; j < 4; ++j) { v0[j] = __logf(bv[bj][0][j] + (1.0f - bv[bj][0][j]) * sigmoidf_(v0[j])); v1[j] = __logf(bv[bj][1][j] + (1.0f - bv[bj][1][j]) * sigmoidf_(v1[j])); }
                                *(f32x4*)(logf + row * 512 + (col - 2048)) = v0; *(f32x4*)(logf + row * 512 + (col - 2048) + 4) = v1; }
                            else if (pn < 12) { *(f16x8*)(ih + row * 512 + (col - 2560)) = pack8(v0, v1); }
                            else if (pn < 14) {
#pragma unroll
                                for (int j = 0; j < 4; ++j) { v0[j] = siluf_(v0[j]); v1[j] = siluf_(v1[j]); }
                                *(f16x8*)(gh + row * 512 + (col - 3072)) = pack8(v0, v1); }
                            else { *(f32x4*)(small + row * 256 + (col - 3584)) = v0; *(f32x4*)(small + row * 256 + (col - 3584) + 4) = v1; }
                        }
                    }
                    if constexpr (MODE == EP_BRA || MODE == EP_BRB || MODE == EP_PLE2) asm volatile("" ::: "memory");
                }
        }
    }
};

template <class EpiT>
__device__ __forceinline__ void gemm_phase(LAS unsigned char* lds, const Gemm g, const StaticOrder& S, const EpiT& E) {
    const int tid = threadIdx.x, wid = __builtin_amdgcn_readfirstlane(tid >> 6), lane = tid & 63, wr = wid >> 2, wc = wid & 3, fr = lane & 15, fq = lane >> 4;
    const int K = g.K, nt = K / BK;
    unsigned voffA[2], voffB[2];
#pragma unroll
    for (int i = 0; i < 2; ++i) { int R, C; stage_rc(tid * 16 + i * 8192, R, C); const int Rb = (R & ~31) + perm32(R & 31);
        voffA[i] = (unsigned)(R * K + C) * 2u; voffB[i] = (unsigned)(Rb * K + C) * 2u; }
    const size_t kstep = (size_t)(BK * 2);
    const size_t hstep = (size_t)HALF * K * 2;
    const size_t tstep = 2 * hstep;
    const unsigned ldsw = (unsigned)wid * 1024u;
    const int aoff = lds_byte(wr * 64 + fr, fq * 8), boff = lds_byte(wc * 32 + fr, fq * 8);
#define PG8_SA(b, h) (((b) * 2 + (h)) * HTB)
#define PG8_SB(b, h) ((4 + (b) * 2 + (h)) * HTB)
#define PG8_STAGE(bufoff, gbase, voff) do { _Pragma("unroll") for (int _i = 0; _i < 2; ++_i) \
        __builtin_amdgcn_global_load_lds((const unsigned*)((const char*)(gbase) + (voff)[_i]), (LAS unsigned*)(lds + (bufoff) + ldsw + _i * 8192), 16, 0, 0); } while (0)
#define PG8_LDA(dst, b, h) do { _Pragma("unroll") for (int m = 0; m < 4; ++m) _Pragma("unroll") for (int k = 0; k < 2; ++k) dst[m][k] = *(const LAS f16x8*)(lds + PG8_SA(b, h) + aoff + m * 2048 + k * 1024); } while (0)
#define PG8_LDB(dst, b, h) do { _Pragma("unroll") for (int n = 0; n < 2; ++n) _Pragma("unroll") for (int k = 0; k < 2; ++k) dst[n][k] = *(const LAS f16x8*)(lds + PG8_SB(b, h) + boff + n * 2048 + k * 1024); } while (0)
#define PG8_MMA(ai, bj, At, Bt) do { __builtin_amdgcn_s_setprio(1); _Pragma("unroll") for (int m = 0; m < 4; ++m) _Pragma("unroll") for (int n = 0; n < 2; ++n) _Pragma("unroll") for (int k = 0; k < 2; ++k) \
        acc[ai][bj][m][n] = __builtin_amdgcn_mfma_f32_16x16x32_f16(Bt[n][k], At[m][k], acc[ai][bj][m][n], 0, 0, 0); __builtin_amdgcn_s_setprio(0); } while (0)
#define PG8_WAIT_V(n) asm volatile("s_waitcnt vmcnt(" #n ")" ::: "memory")
#define PG8_WAIT_L(n) asm volatile("s_waitcnt lgkmcnt(" #n ")" ::: "memory")
#define PG8_BAR __builtin_amdgcn_s_barrier()
#define PG8_SCHED __builtin_amdgcn_sched_barrier(0)
    Unit cur, nxt; int ui = 0;
    if (!S.next(0, cur)) return;
    f32x4 acc[2][2][4][2];
#pragma unroll
    for (int a = 0; a < 2; ++a)
#pragma unroll
        for (int b = 0; b < 2; ++b)
#pragma unroll
            for (int m = 0; m < 4; ++m)
#pragma unroll
                for (int n = 0; n < 2; ++n) acc[a][b][m][n] = (f32x4){0.f, 0.f, 0.f, 0.f};
    f16x8 At[4][2], B0[2][2], B1[2][2];
    const char* cA = (const char*)g.A + (size_t)cur.pm * tstep; const char* cB = (const char*)g.Bt + (size_t)cur.pn * tstep;
    PG8_STAGE(PG8_SB(0, 0), cB, voffB); PG8_STAGE(PG8_SB(0, 1), cB + hstep, voffB); PG8_STAGE(PG8_SA(0, 0), cA, voffA); PG8_STAGE(PG8_SA(0, 1), cA + hstep, voffA);
    if (wr == 1) PG8_BAR;
    PG8_WAIT_V(2); PG8_BAR;
    PG8_STAGE(PG8_SB(1, 0), cB + kstep, voffB); PG8_STAGE(PG8_SA(1, 0), cA + kstep, voffA); PG8_STAGE(PG8_SB(1, 1), cB + hstep + kstep, voffB);
    PG8_WAIT_V(6); PG8_BAR;
    for (;;) {
        const bool has_next = S.next(ui + 1, nxt);
        const char* nA = has_next ? (const char*)g.A + (size_t)nxt.pm * tstep : cA; const char* nB = has_next ? (const char*)g.Bt + (size_t)nxt.pn * tstep : cB;
        for (int t = 0; t < nt; t += 2) {
            const bool last = (t == nt - 2);
            const char* a1 = cA + (size_t)(t + 1) * kstep;
            const char* a2 = last ? nA : cA + (size_t)(t + 2) * kstep; const char* b2 = last ? nB : cB + (size_t)(t + 2) * kstep;
            const char* a3 = a2 + kstep; const char* b3 = b2 + kstep;
            PG8_LDB(B0, 0, 0); PG8_LDB(B1, 0, 1); PG8_SCHED; PG8_LDA(At, 0, 0); PG8_STAGE(PG8_SA(1, 1), a1 + hstep, voffA);
            PG8_WAIT_V(8); PG8_WAIT_L(0); PG8_BAR; PG8_MMA(0, 0, At, B0); PG8_MMA(0, 1, At, B1); PG8_BAR; PG8_SCHED;
            PG8_LDA(At, 0, 1); PG8_STAGE(PG8_SB(0, 0), b2, voffB); PG8_STAGE(PG8_SB(0, 1), b2 + hstep, voffB); PG8_STAGE(PG8_SA(0, 0), a2, voffA);
            PG8_WAIT_V(8); PG8_WAIT_L(0); PG8_BAR; PG8_MMA(1, 0, At, B0); PG8_MMA(1, 1, At, B1); PG8_BAR; PG8_SCHED;
            PG8_LDB(B0, 1, 0); PG8_LDB(B1, 1, 1); PG8_SCHED; PG8_LDA(At, 1, 0); PG8_STAGE(PG8_SA(0, 1), a2 + hstep, voffA);
            PG8_WAIT_V(8); PG8_WAIT_L(0); PG8_BAR; PG8_MMA(0, 0, At, B0); PG8_MMA(0, 1, At, B1); PG8_BAR; PG8_SCHED;
            PG8_LDA(At, 1, 1); PG8_STAGE(PG8_SB(1, 0), b3, voffB); PG8_STAGE(PG8_SB(1, 1), b3 + hstep, voffB); PG8_STAGE(PG8_SA(1, 0), a3, voffA);
            PG8_WAIT_V(8); PG8_WAIT_L(0); PG8_BAR; PG8_MMA(1, 0, At, B0); PG8_MMA(1, 1, At, B1); PG8_BAR; PG8_SCHED;
        }
        if (wr == 0) PG8_BAR;
        E(acc, cur, wr, wc, fr, fq);
        if (!has_next) break;
#pragma unroll
        for (int a = 0; a < 2; ++a)
#pragma unroll
            for (int b = 0; b < 2; ++b)
#pragma unroll
                for (int m = 0; m < 4; ++m)
#pragma unroll
                    for (int n = 0; n < 2; ++n) acc[a][b][m][n] = (f32x4){0.f, 0.f, 0.f, 0.f};
        cur = nxt; cA = nA; cB = nB; ++ui;
        if (wr == 1) PG8_BAR;
    }
    PG8_WAIT_V(0);
    PG8_BAR;
#undef PG8_SA
#undef PG8_SB
#undef PG8_STAGE
#undef PG8_LDA
#undef PG8_LDB
#undef PG8_MMA
#undef PG8_WAIT_V
#undef PG8_WAIT_L
#undef PG8_BAR
#undef PG8_SCHED
}
}

#define XB_TMO      128
#define XB_XCNT(j)  (256  + 64 * (j))
#define XB_XSUB(j)  (1280 + 64 * (j))
#define XB_XGEN(j)  (2304 + 64 * (j))
#define XB_TOP      3328
#define XB_TOPGEN   3392
#define XCD_BAR_WORDS 3456
#define XB_SPIN_CAP (1u << 23)
__device__ __forceinline__ unsigned xb_ld(unsigned* p)              { return __hip_atomic_load(p, __ATOMIC_RELAXED, __HIP_MEMORY_SCOPE_AGENT); }
__device__ __forceinline__ unsigned xb_add(unsigned* p, unsigned v) { return __hip_atomic_fetch_add(p, v, __ATOMIC_RELAXED, __HIP_MEMORY_SCOPE_AGENT); }
__device__ __forceinline__ unsigned xb_xcc_id() { return (unsigned)__builtin_amdgcn_s_getreg((3 << 11) | 20) & 0xFu; }
#define XB_SPIN(cond, bar) do { unsigned _sp = 0; while (cond) { __builtin_amdgcn_s_sleep(1); \
    if ((++_sp & 255u) == 0u) { if (xb_ld(&(bar)[XB_TMO])) break; if (_sp > XB_SPIN_CAP) { atomicAdd(&(bar)[XB_TMO], 1u); break; } } } } while (0)
struct XcdBarrier { unsigned* bar; unsigned x; volatile LAS unsigned* st; };
__device__ __forceinline__ XcdBarrier xcd_barrier_post(unsigned* bar, volatile LAS unsigned* st) {
    XcdBarrier b; b.bar = bar; b.x = xb_xcc_id(); b.st = st;
    if (threadIdx.x == 0) (void)xb_add(&bar[XB_XCNT(b.x)], 1u);
    return b;
}
__device__ __forceinline__ void xcd_barrier_complete(unsigned* bar, unsigned x, unsigned& nloc, unsigned& nx) {
    const unsigned G = gridDim.x * gridDim.y * gridDim.z;
    unsigned sum, cnt, mine, sp = 0u;
    for (;;) {
        sum = 0u; cnt = 0u; mine = 0u;
#pragma unroll
        for (unsigned j = 0; j < 16; ++j) { const unsigned c = xb_ld(&bar[XB_XCNT(j)]); sum += c; cnt += (c > 0u) ? 1u : 0u; mine = (j == x) ? c : mine; }
        if (sum == G) break;
        __builtin_amdgcn_s_sleep(1);
        if ((++sp & 255u) == 0u) { if (xb_ld(&bar[XB_TMO])) break; if (sp > XB_SPIN_CAP) { atomicAdd(&bar[XB_TMO], 1u); break; } }
    }
    nloc = mine > 0u ? mine : 1u; nx = cnt > 0u ? cnt : 1u;
}
__device__ __forceinline__ void xcd_barrier(const XcdBarrier& b) {
    asm volatile("s_waitcnt vmcnt(0)" ::: "memory");
    __syncthreads();
    if (threadIdx.x == 0) {
        unsigned* bar = b.bar;
        __builtin_amdgcn_s_waitcnt(0);
        unsigned nloc = b.st[0], nx = b.st[1];
        if (nloc == 0u) { xcd_barrier_complete(bar, b.x, nloc, nx); b.st[0] = nloc; b.st[1] = nx; }
        const unsigned old = xb_add(&bar[XB_XSUB(b.x)], 1u);
        const unsigned gen = old / nloc;
        if (old + 1u == (gen + 1u) * nloc) {
            __builtin_amdgcn_fence(__ATOMIC_RELEASE, "agent");
            asm volatile("s_waitcnt vmcnt(0)" ::: "memory");
            const unsigned og = xb_add(&bar[XB_TOP], 1u);
            const unsigned tg = og / nx;
            if (og + 1u == (tg + 1u) * nx) xb_add(&bar[XB_TOPGEN], 1u);
            else XB_SPIN(xb_ld(&bar[XB_TOPGEN]) == tg, bar);
            __builtin_amdgcn_fence(__ATOMIC_ACQUIRE, "agent");
            xb_add(&bar[XB_XGEN(b.x)], 1u);
            asm volatile("s_waitcnt vmcnt(0)" ::: "memory");
        } else {
            XB_SPIN(xb_ld(&bar[XB_XGEN(b.x)]) == gen, bar);
            __builtin_amdgcn_fence(__ATOMIC_ACQUIRE, "agent");
            asm volatile("s_waitcnt vmcnt(0)" ::: "memory");
        }
    }
    __syncthreads();
}

struct TJ { int in, ldn, col0, K; unsigned long long dst; int row0, ncols, nvalid, il; };
constexpr int NTJ = 21;
__constant__ TJ tjobs[NTJ] = {
    {6, FF, 0, DM, W_GU1, 0, FF, FF, 1},      {7, FF, 0, DM, W_GU1, 128, FF, FF, 1},   {8, DM, 0, FF, W_D1, 0, DM, DM, 0},
    {23, FF, 0, DM, W_GU2, 0, FF, FF, 1},     {24, FF, 0, DM, W_GU2, 128, FF, FF, 1},  {25, DM, 0, FF, W_D2, 0, DM, DM, 0},
    {11, 5320, 640, DM, W_IN, 1024, 512, 512, 0},  {11, 5320, 1224, DM, W_IN, 1536, 512, 512, 0}, {11, 5320, 1736, DM, W_IN, 2048, 512, 512, 0},
    {11, 5320, 2248, DM, W_IN, 2560, 512, 512, 0}, {11, 5320, 2760, DM, W_IN, 3072, 512, 512, 0}, {11, 5320, 512, DM, W_IN, 3584, 128, 128, 0},
    {11, 5320, 1152, DM, W_IN, 3712, 64, 64, 0},   {11, 5320, 1216, DM, W_IN, 3776, 32, 8, 0},    {11, 5320, 0, DM, W_IN, 3808, 32, 0, 0},
    {11, 5320, 3272, DM, W_G, 0, 1024, 1024, 0},   {11, 5320, 4296, DM, W_G, 1024, 1024, 1024, 0},
    {18, DM, 0, 512, W_BRB, 0, DM, DM, 0},    {20, DM, 0, DM, W_OUT, 0, DM, DM, 0},    {28, DM, 0, DM, W_PG, 0, DM, DM, 0},      {29, DM, 0, PLE, W_PP, 0, DM, DM, 0},
};
__device__ __forceinline__ void transpose_item(const float* W, int ldn, int col0, int K, f16* WT, int row0, int nvalid, int il, LAS float* scr, int item, int ncols, int lane) {
    const int nblk = ncols / 32, kb = item / nblk, nb = item % nblk, k0 = 64 * kb, n0 = 32 * nb;
#pragma unroll 8
    for (int i = 0; i < 32; ++i) { const int kk = 2 * i + (lane >> 5); scr[kk * 33 + (lane & 31)] = W[(size_t)(k0 + kk) * ldn + col0 + n0 + (lane & 31)]; }
    LDS_WAIT();
    const int c = lane & 7;
#pragma unroll
    for (int j = 0; j < 4; ++j) { const int n = (lane >> 3) + 8 * j; const LAS float* s = scr + (8 * c) * 33 + n;
        f16x8 o;
#pragma unroll
        for (int e = 0; e < 8; ++e) o[e] = (n0 + n < nvalid) ? (f16)s[e * 33] : (f16)0.f;
        const int nn = n0 + n; const int drow = il ? (row0 + 256 * (nn >> 7) + (nn & 127)) : (row0 + nn);
        *(f16x8*)(WT + (size_t)drow * K + k0 + 8 * c) = o; }
    LDS_WAIT();
}

__device__ __forceinline__ void row_update(const float* hin, const f16* y, const float* gpost, float scale, float* hout, const float* gnext, f16* xn, int lane) {
    f32x4 h[4], yv[4]; float ss = 0.f;
#pragma unroll
    for (int j = 0; j < 4; ++j) { const int c = (lane + 64 * j) * 4; const f16x4 t = *(const f16x4*)(y + c); yv[j] = (f32x4){(float)t[0], (float)t[1], (float)t[2], (float)t[3]}; h[j] = *(const f32x4*)(hin + c);
        ss += (yv[j][0] * yv[j][0] + yv[j][1] * yv[j][1]) + (yv[j][2] * yv[j][2] + yv[j][3] * yv[j][3]); }
    const float rstd = scale * __builtin_amdgcn_rsqf(wave_sum(ss) * (1.f / DM) + EPS);
    float s2 = 0.f;
#pragma unroll
    for (int j = 0; j < 4; ++j) { const int c = (lane + 64 * j) * 4; const f32x4 g = *(const f32x4*)(gpost + c); h[j] = h[j] + yv[j] * rstd * g;
        s2 += (h[j][0] * h[j][0] + h[j][1] * h[j][1]) + (h[j][2] * h[j][2] + h[j][3] * h[j][3]); *(f32x4*)(hout + c) = h[j]; }
    if (gnext) {
        const float r2 = __builtin_amdgcn_rsqf(wave_sum(s2) * (1.f / DM) + EPS);
#pragma unroll
        for (int j = 0; j < 4; ++j) { const int c = (lane + 64 * j) * 4; const f32x4 g = *(const f32x4*)(gnext + c); const f32x4 o = h[j] * r2 * g;
            f16x4 w; w[0] = (f16)o[0]; w[1] = (f16)o[1]; w[2] = (f16)o[2]; w[3] = (f16)o[3]; *(f16x4*)(xn + c) = w; }
    }
}

__global__ void __launch_bounds__(NTHREADS, 2) mk_fwd(Args args_unused) {
    extern __shared__ __attribute__((aligned(16))) unsigned char lds_raw[];
    LAS unsigned char* lds = (LAS unsigned char*)lds_raw;
    const int tid = threadIdx.x, lane = tid & 63, wave = __builtin_amdgcn_readfirstlane(tid >> 6);
    const int G = gridDim.x; const int bx = blockIdx.x; const int vcu = (G % 8 == 0) ? (bx % 8) * (G / 8) + bx / 8 : bx;
    const int gw = vcu * NWAVES + wave, NGW = G * NWAVES;
    typedef const __attribute__((address_space(4))) Args* CArgsP;
    const CArgsP ap0 = (CArgsP)__builtin_amdgcn_kernarg_segment_ptr();
    unsigned* ctl = (unsigned*)(ap0->ws + WS_CTL);
    volatile LAS unsigned* MISC = (volatile LAS unsigned*)(lds + LDSCTL_OFF);
    for (int u = tid; u < 128; u += NTHREADS) MISC[u] = 0u;
    __syncthreads();
    const int lo = ap0->ph_lo, hi = ap0->ph_hi;
    XcdBarrier bar; bar.bar = ctl + CW_BAR; bar.x = 0; bar.st = nullptr;
    if (hi - lo > 1) bar = xcd_barrier_post(ctl + CW_BAR, MISC + 8);
#ifndef MK_PHASE_MASK
#define MK_PHASE_MASK 0xFFFFFFFFu
#endif
#define IN(k) ((((MK_PHASE_MASK) >> (k)) & 1u) && lo <= (k) && (k) < hi)
#ifndef MK_REP_MASK
#define MK_REP_MASK 0u
#endif
#define REPS(k) ((((MK_REP_MASK) >> (k)) & 1u) ? 2 : 1)
#define SEAM(k) do { if (IN(k) && IN((k) + 1)) xcd_barrier(bar); } while (0)

#define PH_BEGIN() CArgsP ap = ap0; asm volatile("" : "+s"(ap)); const __attribute__((address_space(4))) Args& args = *ap; unsigned char* const ws = args.ws; (void)ws; \
    f16* const XN = (f16*)(ws + WS_XN); f16* const Y = (f16*)(ws + WS_Y); f16* const ACT = (f16*)(ws + WS_ACT); \
    f16* const QLAT = (f16*)(ws + WS_QLAT); f16* const QIDX = (f16*)(ws + WS_QIDX); f16* const QH = (f16*)(ws + WS_QH); f16* const IH = (f16*)(ws + WS_IH); \
    f16* const GH = (f16*)(ws + WS_GH); float* const LOGF = (float*)(ws + WS_LOGF); float* const SMALL = (float*)(ws + WS_SMALL); \
    f16* const CKV = (f16*)(ws + WS_CKV); f16* const KIDX = (f16*)(ws + WS_KIDX); float* const WQ = (float*)(ws + WS_WQ); f16* const P16 = (f16*)(ws + WS_P16); \
    f16* const OH = (f16*)(ws + WS_OH); f16* const YB = (f16*)(ws + WS_YB); f16* const GT = (f16*)(ws + WS_G); f16* const MERGED = (f16*)(ws + WS_MERGED); f16* const GP = (f16*)(ws + WS_GP); \
    float* const LB = (float*)(ws + W_LB); float* const HOUT = args.out; \
    (void)XN; (void)Y; (void)ACT; (void)QLAT; (void)QIDX; (void)QH; (void)IH; (void)GH; (void)LOGF; (void)SMALL; (void)CKV; (void)KIDX; (void)WQ; (void)P16; (void)OH; (void)YB; (void)GT; (void)MERGED; (void)GP; (void)LB; (void)HOUT;

    if (IN(0)) for (int rep_ = 0; rep_ < REPS(0); ++rep_) { PH_BEGIN();
        if (vcu < 32) {
            LAS float* wl = (LAS float*)lds;
            const bool isq = vcu < 16; const int v2 = isq ? vcu : vcu - 16; const int h = v2 >> 1; const int idx = (v2 & 1) * 512 + tid;
            const float* src = (isq ? args.in[14] : args.in[15]) + (size_t)h * 128 * 64;
            for (int i = tid; i < 128 * 64; i += NTHREADS) wl[i] = src[i];
            __syncthreads();
            float a[64];
            if (isq) {
                const float* win = args.in[11] + (size_t)idx * 5320 + h * 64;
#pragma unroll
                for (int d = 0; d < 64; ++d) a[d] = win[d];
                f16* dst = (f16*)(ws + W_IN);
                for (int c = 0; c < 128; ++c) { float s = 0.f;
#pragma unroll
                    for (int d = 0; d < 64; ++d) s += a[d] * wl[c * 64 + d];
                    dst[(size_t)(h * 128 + c) * DM + idx] = (f16)s; }
            } else {
                const float* wb = args.in[17] + (size_t)(h * 64) * DM + idx;
#pragma unroll
                for (int d = 0; d < 64; ++d) a[d] = wb[(size_t)d * DM];
                f16* dst = (f16*)(ws + W_UVBR) + (size_t)idx * DM + h * 128;
                for (int c8 = 0; c8 < 16; ++c8) { f16x8 o;
#pragma unroll
                    for (int e = 0; e < 8; ++e) { float s = 0.f; const int c = c8 * 8 + e;
#pragma unroll
                        for (int d = 0; d < 64; ++d) s += a[d] * wl[c * 64 + d];
                        o[e] = (f16)s; }
                    *(f16x8*)(dst + c8 * 8) = o; }
            }
            __syncthreads();
        }
        if (vcu == 32 && tid < 512) { const float a0 = args.in[3][tid], a1 = args.in[3][512 + tid]; LB[tid] = 1.0f / (1.0f + __expf(a1 - a0)); }
        LAS float* scr = (LAS float*)(lds + wave * 16384);
        int tot = 0;
        for (int j = 0; j < NTJ; ++j) tot += (tjobs[j].K / 64) * (tjobs[j].ncols / 32);
        for (int it = gw; it < tot; it += NGW) {
            int r = it, j = 0;
            for (; j < NTJ; ++j) { const int n = (tjobs[j].K / 64) * (tjobs[j].ncols / 32); if (r < n) break; r -= n; }
            const TJ t = tjobs[j];
            transpose_item(args.in[t.in], t.ldn, t.col0, t.K, (f16*)(ws + t.dst), t.row0, t.nvalid, t.il, scr, r, t.ncols, lane);
        }
        for (int m = gw; m < M; m += NGW) {
            const float* xr = args.in[0] + (size_t)m * DM; f32x4 v[4]; float ss = 0.f;
#pragma unroll
            for (int j = 0; j < 4; ++j) { v[j] = *(const f32x4*)(xr + (lane + 64 * j) * 4); ss += (v[j][0] * v[j][0] + v[j][1] * v[j][1]) + (v[j][2] * v[j][2] + v[j][3] * v[j][3]); }
            const float rstd = __builtin_amdgcn_rsqf(wave_sum(ss) * (1.f / DM) + EPS);
#pragma unroll
            for (int j = 0; j < 4; ++j) { const int c = (lane + 64 * j) * 4; const f32x4 g = *(const f32x4*)(args.in[4] + c); const f32x4 o = v[j] * rstd * g;
                f16x4 w; w[0] = (f16)o[0]; w[1] = (f16)o[1]; w[2] = (f16)o[2]; w[3] = (f16)o[3]; *(f16x4*)(XN + (size_t)m * DM + c) = w; }
            const f32x4 pv = *(const f32x4*)(args.in[1] + (size_t)m * PLE + lane * 4);
            f16x4 w; w[0] = (f16)pv[0]; w[1] = (f16)pv[1]; w[2] = (f16)pv[2]; w[3] = (f16)pv[3]; *(f16x4*)(P16 + (size_t)m * PLE + lane * 4) = w;
        }
    }
    SEAM(0);
    if (IN(1)) for (int rep_ = 0; rep_ < REPS(1); ++rep_) { PH_BEGIN(); pg8::Gemm g{XN, (const f16*)(ws + W_GU1), M, 2 * FF, DM}; pg8::StaticOrder S; S.init(M, 2 * FF, G, bx);
        pg8::Epi<pg8::EP_SWIGLU> E{}; E.O = ACT; E.ldc = FF; pg8::gemm_phase(lds, g, S, E); }
    SEAM(1);
    if (IN(2)) for (int rep_ = 0; rep_ < REPS(2); ++rep_) { PH_BEGIN(); pg8::Gemm g{ACT, (const f16*)(ws + W_D1), M, DM, FF}; pg8::StaticOrder S; S.init(M, DM, G, bx);
        pg8::Epi<pg8::EP_F16> E{}; E.O = Y; E.ldc = DM; pg8::gemm_phase(lds, g, S, E); }
    SEAM(2);
    if (IN(3)) for (int rep_ = 0; rep_ < REPS(3); ++rep_) { PH_BEGIN(); for (int m = gw; m < M; m += NGW) row_update(args.in[0] + (size_t)m * DM, Y + (size_t)m * DM, args.in[5], 0.5f, HOUT + (size_t)m * DM, args.in[9], XN + (size_t)m * DM, lane); }
    SEAM(3);
    if (IN(4)) for (int rep_ = 0; rep_ < REPS(4); ++rep_) { PH_BEGIN(); pg8::Gemm g{XN, (const f16*)(ws + W_IN), M, NIN, DM}; pg8::StaticOrder S; S.init(M, NIN, G, bx);
        pg8::Epi<pg8::EP_INPROJ> E{}; E.qlat = QLAT; E.qidx = QIDX; E.qh = QH; E.ih = IH; E.gh = GH; E.logf = LOGF; E.small = SMALL; E.lb = LB; pg8::gemm_phase(lds, g, S, E); }
    SEAM(4);
    if (IN(5)) for (int rep_ = 0; rep_ < REPS(5); ++rep_) { PH_BEGIN();
        for (int m = gw; m < M; m += NGW) {
            const float* sr = SMALL + (size_t)m * 256;
            const f32x2 c2 = *(const f32x2*)(sr + 2 * lane); const float k1 = sr[128 + lane];
            const float rc = __builtin_amdgcn_rsqf(wave_sum(c2[0] * c2[0] + c2[1] * c2[1]) * (1.f / 128.f) + EPS);
            const float rk = __builtin_amdgcn_rsqf(wave_sum(k1 * k1) * (1.f / 64.f) + EPS);
            const f32x2 gc = *(const f32x2*)(args.in[12] + 2 * lane);
            f16x2 o; o[0] = (f16)(c2[0] * rc * gc[0]); o[1] = (f16)(c2[1] * rc * gc[1]); *(f16x2*)(CKV + (size_t)m * 128 + 2 * lane) = o;
            KIDX[(size_t)m * 64 + lane] = (f16)(k1 * rk * args.in[13][lane]);
            if (lane < 8) WQ[(size_t)m * 8 + lane] = sr[192 + lane] * 0.04419417382415922f;
        }
    }
    SEAM(5);
    if (IN(6)) for (int rep_ = 0; rep_ < REPS(6); ++rep_) { PH_BEGIN();
        constexpr int H_GF = 0, H_TOT = 16384, H_QS = 18432, H_Q1 = 26624, H_K0 = 30720, H_K1 = 34816, H_KST = 43008, H_V = 51200, H_D = 52224, H_OT = 52736;
        for (int unit = vcu; unit < 256; unit += G) {
            const int b = unit >> 5, h = (unit >> 3) & 3, vg = unit & 7;
            const int t = tid >> 4, ch = tid & 15, fr = lane & 15, fg = lane >> 4;
            const size_t rowbase = (size_t)b * SEQ * 512 + h * 128;
            f32x4 S[8];
#pragma unroll
            for (int m = 0; m < 8; ++m) S[m] = (f32x4){0.f, 0.f, 0.f, 0.f};
            f32x4 ga, gb; f16x8 qv, vv = {};
            { const size_t ro = rowbase + (size_t)t * 512 + 8 * ch; ga = *(const f32x4*)(LOGF + ro); gb = *(const f32x4*)(LOGF + ro + 4); qv = *(const f16x8*)(QH + ro);
              if (tid < 64) vv = *(const f16x8*)(IH + rowbase + (size_t)(tid >> 1) * 512 + vg * 16 + 8 * (tid & 1)); }
            for (int c = 0; c < SEQ / 32; ++c) {
                *(LAS f32x4*)(lds + H_GF + t * 512 + ch * 32) = ga; *(LAS f32x4*)(lds + H_GF + t * 512 + ch * 32 + 16) = gb;
                if (tid < 64) { u32x4 w; w[0] = pk_bf16((float)vv[0], (float)vv[1]); w[1] = pk_bf16((float)vv[2], (float)vv[3]); w[2] = pk_bf16((float)vv[4], (float)vv[5]); w[3] = pk_bf16((float)vv[6], (float)vv[7]);
                    *(LAS u32x4*)(lds + H_V + (tid >> 1) * 32 + (tid & 1) * 16) = w; }
                const f32x4 g0 = ga, g1 = gb; const f16x8 q8r = qv;
                if (c + 1 < SEQ / 32) { const size_t ro = rowbase + (size_t)(32 * (c + 1) + t) * 512 + 8 * ch; ga = *(const f32x4*)(LOGF + ro); gb = *(const f32x4*)(LOGF + ro + 4); qv = *(const f16x8*)(QH + ro);
                    if (tid < 64) vv = *(const f16x8*)(IH + rowbase + (size_t)(32 * (c + 1) + (tid >> 1)) * 512 + vg * 16 + 8 * (tid & 1)); }
                LDS_WAIT(); __syncthreads();
                { const int k = tid & 127, part = tid >> 7; LAS float* gf = (LAS float*)(lds + H_GF) + (8 * part) * 128 + k; float acc = 0.f;
#pragma unroll
                  for (int i = 0; i < 8; ++i) { acc += gf[i * 128]; gf[i * 128] = acc; }
                  ((LAS float*)(lds + H_TOT))[part * 128 + k] = acc; }
                LDS_WAIT(); __syncthreads();
                {
                    const LAS float* gfr = (const LAS float*)(lds + H_GF); const LAS float* tot = (const LAS float*)(lds + H_TOT);
                    f32x4 G0 = *(const LAS f32x4*)(gfr + t * 128 + 8 * ch), G1 = *(const LAS f32x4*)(gfr + t * 128 + 8 * ch + 4);
                    const f32x4 t0a = *(const LAS f32x4*)(tot + 8 * ch), t0b = *(const LAS f32x4*)(tot + 8 * ch + 4);
                    const f32x4 t1a = *(const LAS f32x4*)(tot + 128 + 8 * ch), t1b = *(const LAS f32x4*)(tot + 128 + 8 * ch + 4);
                    const f32x4 t2a = *(const LAS f32x4*)(tot + 256 + 8 * ch), t2b = *(const LAS f32x4*)(tot + 256 + 8 * ch + 4);
                    const int part = t >> 3;
                    if (part >= 1) { G0 += t0a; G1 += t0b; } if (part >= 2) { G0 += t1a; G1 += t1b; } if (part >= 3) { G0 += t2a; G1 += t2b; }
                    const f32x4 G15a = *(const LAS f32x4*)(gfr + 15 * 128 + 8 * ch) + t0a, G15b = *(const LAS f32x4*)(gfr + 15 * 128 + 8 * ch + 4) + t0b;
                    const f32x4 GLa = *(const LAS f32x4*)(gfr + 31 * 128 + 8 * ch) + t0a + t1a + t2a, GLb = *(const LAS f32x4*)(gfr + 31 * 128 + 8 * ch + 4) + t0b + t1b + t2b;
                    float Gv[8], G15[8], GL[8], gr[8], qf[8];
#pragma unroll
                    for (int j = 0; j < 4; ++j) { Gv[j] = G0[j]; Gv[4 + j] = G1[j]; G15[j] = G15a[j]; G15[4 + j] = G15b[j]; GL[j] = GLa[j]; GL[4 + j] = GLb[j]; gr[j] = g0[j]; gr[4 + j] = g1[j]; }
#pragma unroll
                    for (int j = 0; j < 8; ++j) qf[j] = (float)q8r[j];
                    float qs[8], kst[8], x1[8], x2[8];
#pragma unroll
                    for (int j = 0; j < 8; ++j) { const float kk = 1.0f - __expf(gr[j]);
                        qs[j] = qf[j] * __expf(Gv[j]); kst[j] = kk * __expf(GL[j] - Gv[j]);
                        if (t < 16) { x1[j] = kk * __expf(fminf(-Gv[j], 80.f)); x2[j] = kk * __expf(G15[j] - Gv[j]); }
                        else { x1[j] = qf[j] * __expf(Gv[j] - G15[j]); x2[j] = kk * __expf(fminf(G15[j] - Gv[j], 80.f)); } }
                    u32x4 w;
#define HG_STORE(base, row, arr) do { w[0] = pk_bf16(arr[0], arr[1]); w[1] = pk_bf16(arr[2], arr[3]); w[2] = pk_bf16(arr[4], arr[5]); w[3] = pk_bf16(arr[6], arr[7]); *(LAS u32x4*)(lds + (base) + off_b((row), ch)) = w; } while (0)
                    HG_STORE(H_QS, t, qs); HG_STORE(H_KST, t, kst); HG_STORE(H_K1, t, x2);
                    if (t < 16) HG_STORE(H_K0, t, x1); else HG_STORE(H_Q1, t - 16, x1);
#undef HG_STORE
                    if (t == 0) { f32x4 d0, d1;
#pragma unroll
                        for (int j = 0; j < 4; ++j) { d0[j] = __expf(GL[j]); d1[j] = __expf(GL[4 + j]); }
                        *(LAS f32x4*)(lds + H_D + 32 * ch) = d0; *(LAS f32x4*)(lds + H_D + 32 * ch + 16) = d1; }
                }
                LDS_WAIT(); __syncthreads();
                f32x4 oi[2] = {{0.f, 0.f, 0.f, 0.f}, {0.f, 0.f, 0.f, 0.f}};
                const int q_ = fr >> 2, p_ = fr & 3;
                if (wave == 1) {
                    f32x4 at00 = {0.f, 0.f, 0.f, 0.f}, at10 = at00, at11 = at00;
#pragma unroll
                    for (int ks = 0; ks < 4; ++ks) {
                        const bf16x8 k0f = *(const LAS bf16x8*)(lds + H_K0 + off_b(fr, 4 * ks + fg)), q0f = *(const LAS bf16x8*)(lds + H_QS + off_b(fr, 4 * ks + fg));
                        const bf16x8 k1a = *(const LAS bf16x8*)(lds + H_K1 + off_b(fr, 4 * ks + fg)), k1b = *(const LAS bf16x8*)(lds + H_K1 + off_b(16 + fr, 4 * ks + fg));
                        const bf16x8 q1f = *(const LAS bf16x8*)(lds + H_Q1 + off_b(fr, 4 * ks + fg));
                        at00 = __builtin_amdgcn_mfma_f32_16x16x32_bf16(k0f, q0f, at00, 0, 0, 0);
                        at10 = __builtin_amdgcn_mfma_f32_16x16x32_bf16(k1a, q1f, at10, 0, 0, 0);
                        at11 = __builtin_amdgcn_mfma_f32_16x16x32_bf16(k1b, q1f, at11, 0, 0, 0);
                    }
#pragma unroll
                    for (int r = 0; r < 4; ++r) { if (4 * fg + r > fr) { at00[r] = 0.f; at11[r] = 0.f; } }
                    const bf16x8 vt = cat44(lds_tr16(lds + H_V + (4 * fg + q_) * 32 + 8 * p_), lds_tr16(lds + H_V + (16 + 4 * fg + q_) * 32 + 8 * p_));
                    const f32x4 z = {0.f, 0.f, 0.f, 0.f};
                    const f32x4 o0 = __builtin_amdgcn_mfma_f32_16x16x32_bf16(vt, pack_bf8(at00, z), z, 0, 0, 0);
                    const f32x4 o1 = __builtin_amdgcn_mfma_f32_16x16x32_bf16(vt, pack_bf8(at10, at11), z, 0, 0, 0);
                    *(LAS f32x4*)(lds + H_OT + lane * 16) = o0; *(LAS f32x4*)(lds + H_OT + 1024 + lane * 16) = o1;
                } else if (wave == 0) {
#pragma unroll
                    for (int ks = 0; ks < 4; ++ks) {
                        const bf16x8 sop = pack_bf8(S[2 * ks], S[2 * ks + 1]);
#pragma unroll
                        for (int blk = 0; blk < 2; ++blk) {
                            const s16x4 qa = *(const LAS s16x4*)(lds + H_QS + off_b(16 * blk + fr, 4 * ks + (fg >> 1)) + 8 * (fg & 1));
                            const s16x4 qb = *(const LAS s16x4*)(lds + H_QS + off_b(16 * blk + fr, 4 * ks + 2 + (fg >> 1)) + 8 * (fg & 1));
                            oi[blk] = __builtin_amdgcn_mfma_f32_16x16x32_bf16(sop, cat44(qa, qb), oi[blk], 0, 0, 0);
                        }
                    }
                    const bf16x8 vb = cat44(lds_tr16(lds + H_V + (8 * fg + q_) * 32 + 8 * p_), lds_tr16(lds + H_V + (8 * fg + 4 + q_) * 32 + 8 * p_));
#pragma unroll
                    for (int m = 0; m < 8; ++m) {
                        const bf16x8 ka = cat44(lds_tr16(lds + H_KST + off_b(8 * fg + q_, 2 * m + (p_ >> 1)) + 8 * (p_ & 1)), lds_tr16(lds + H_KST + off_b(8 * fg + 4 + q_, 2 * m + (p_ >> 1)) + 8 * (p_ & 1)));
                        const f32x4 dv = *(const LAS f32x4*)(lds + H_D + (16 * m + 4 * fg) * 4);
                        S[m] = __builtin_amdgcn_mfma_f32_16x16x32_bf16(ka, vb, S[m] * dv, 0, 0, 0);
                    }
                }
                LDS_WAIT(); __syncthreads();
                if (wave == 0) {
#pragma unroll
                    for (int blk = 0; blk < 2; ++blk) {
                        const f32x4 o = oi[blk] + *(const LAS f32x4*)(lds + H_OT + blk * 1024 + lane * 16);
                        f16x4 w; w[0] = (f16)o[0]; w[1] = (f16)o[1]; w[2] = (f16)o[2]; w[3] = (f16)o[3];
                        *(f16x4*)(OH + rowbase + (size_t)(32 * c + 16 * blk + fr) * 512 + vg * 16 + 4 * fg) = w;
                    }
                }
            }
            __syncthreads();
        }
    }
    SEAM(6);
    if (IN(7)) for (int rep_ = 0; rep_ < REPS(7); ++rep_) { PH_BEGIN();
        for (int m = gw; m < M; m += NGW) {
            const f16x8 o8 = *(const f16x8*)(OH + (size_t)m * 512 + 8 * lane), g8 = *(const f16x8*)(GH + (size_t)m * 512 + 8 * lane);
            float ss = 0.f;
#pragma unroll
            for (int e = 0; e < 8; ++e) ss += (float)o8[e] * (float)o8[e];
            ss += __shfl_xor(ss, 1); ss += __shfl_xor(ss, 2); ss += __shfl_xor(ss, 4); ss += __shfl_xor(ss, 8);
            const float r = __builtin_amdgcn_rsqf(ss * (1.f / 128.f) + EPS);
            const float* gn = args.in[16] + (8 * lane & 127);
            f16x8 w;
#pragma unroll
            for (int e = 0; e < 8; ++e) w[e] = (f16)((float)o8[e] * r * gn[e] * (float)g8[e]);
            *(f16x8*)(YB + (size_t)m * 512 + 8 * lane) = w;
        }
        LAS float* relb = (LAS float*)(lds + TAB_OFF); LAS int* bkt = (LAS int*)(lds + TAB_OFF + 2048);
        relb[tid] = ((tid & 15) < 8) ? args.in[2][(tid >> 4) * 8 + (tid & 15)] : 0.f;
        if (tid < 128) { int bk = tid; if (tid >= 16) { const float vv = __logf((float)tid / 16.f) / 2.0794415416798357f * 16.f; bk = 16 + (int)vv; bk = bk > 31 ? 31 : bk; } bkt[tid] = bk; }
        __syncthreads();
        LAS unsigned char* const cbuf = lds + wave * 16384;
        LAS unsigned* const lst = (LAS unsigned*)(lds + WSM_OFF + wave * WSM_BYTES);
        unsigned* const SCR = (unsigned*)(ws + WS_QH) + (size_t)bx * (16 * 4096);
        for (int un = bx; un < 2048; un += G) {
            const int b = un & 7, idx = un >> 3, jj_ = idx & 31, kk_ = idx >> 5; const int qt = (kk_ & 1) ? 32 * kk_ + 31 - jj_ : 32 * kk_ + jj_;
            const int q0 = b * SEQ + 16 * qt;
            int ln_ = lane; asm volatile("" : "+v"(ln_));
            const int fr = ln_ & 15, fg = ln_ >> 4, q_ = fr >> 2, p_ = fr & 3;
            {
                f16x8 Qf[8][2];
                const f16* qp = QIDX + (size_t)(q0 + fr) * 512 + 8 * fg;
#pragma unroll
                for (int h = 0; h < 8; ++h) { Qf[h][0] = *(const f16x8*)(qp + h * 64); Qf[h][1] = *(const f16x8*)(qp + h * 64 + 32); }
                const f32x4 w0 = *(const f32x4*)(WQ + (size_t)(q0 + fr) * 8), w1 = *(const f32x4*)(WQ + (size_t)(q0 + fr) * 8 + 4);
                const int nkt = qt + 1;
                const f16* kp0 = KIDX + ((size_t)b * SEQ + fr) * 64 + 8 * fg;
                f16x8 A0n = {0, 0, 0, 0, 0, 0, 0, 0}, A1n = A0n;
                if (wave < nkt) { A0n = *(const f16x8*)(kp0 + (size_t)wave * 1024); A1n = *(const f16x8*)(kp0 + (size_t)wave * 1024 + 32); }
                for (int kt = wave; kt < nkt; kt += 8) {
                    const f16x8 A0 = A0n, A1 = A1n;
                    if (kt + 8 < nkt) { A0n = *(const f16x8*)(kp0 + (size_t)(kt + 8) * 1024); A1n = *(const f16x8*)(kp0 + (size_t)(kt + 8) * 1024 + 32); }
                    f32x4 sc4 = {0.f, 0.f, 0.f, 0.f};
#pragma unroll
                    for (int h = 0; h < 8; ++h) {
                        f32x4 d = __builtin_amdgcn_mfma_f32_16x16x32_f16(A0, Qf[h][0], (f32x4){0.f, 0.f, 0.f, 0.f}, 0, 0, 0);
                        d = __builtin_amdgcn_mfma_f32_16x16x32_f16(A1, Qf[h][1], d, 0, 0, 0);
                        const float wh = h < 4 ? w0[h] : w1[h - 4];
#pragma unroll
                        for (int r = 0; r < 4; ++r) sc4[r] += wh * fmaxf(d[r], 0.f);
                    }
                    u32x4 o;
#pragma unroll
                    for (int r = 0; r < 4; ++r) { const unsigned x = __float_as_uint(sc4[r]); o[r] = (x & 0x80000000u) ? (x ^ 0x7FFFFFFFu) : x; }
                    *(u32x4*)(SCR + fr * 4096 + 16 * kt + 4 * fg) = o;
                }
            }
            VM_WAIT(); __syncthreads();
            int n0 = 0, n1 = 0;
            for (int qq = 0; qq < 2; ++qq) {
                const int qi = 2 * wave + qq, t = 16 * qt + qi;
                LAS unsigned* const lq = lst + qq * 256;
                const unsigned* sp = SCR + qi * 4096;
                int uk[64];
                constexpr int PAD = (int)0x80000000;
#pragma unroll
                for (int j = 0; j < 16; ++j) {
                    const u32x4 v = *(const u32x4*)(sp + 256 * j + 4 * lane);
#pragma unroll
                    for (int e = 0; e < 4; ++e) uk[4 * j + e] = (256 * j + 4 * lane + e <= t) ? (int)v[e] : PAD;
                }
#define CNT_GE(dst, thr_) do { unsigned s0_ = 0u, s1_ = 0u, s2_ = 0u, s3_ = 0u; const int th_ = (thr_); _Pragma("unroll") for (int i_ = 0; i_ < 16; ++i_) { \
                    s0_ = __builtin_amdgcn_alignbit(s0_, (unsigned)__builtin_elementwise_sub_sat(uk[i_], th_), 31); s1_ = __builtin_amdgcn_alignbit(s1_, (unsigned)__builtin_elementwise_sub_sat(uk[16 + i_], th_), 31); \
                    s2_ = __builtin_amdgcn_alignbit(s2_, (unsigned)__builtin_elementwise_sub_sat(uk[32 + i_], th_), 31); s3_ = __builtin_amdgcn_alignbit(s3_, (unsigned)__builtin_elementwise_sub_sat(uk[48 + i_], th_), 31); } \
                    dst = 4096 - wave_total_i(__popc(s0_) + __popc(s1_) + __popc(s2_) + __popc(s3_)); } while (0)
                int Tk = PAD, r = 0, ceq = 0;
                if (t + 1 > 256) {
                    int umx = PAD, umn = 0x7FFFFFFF;
#pragma unroll
                    for (int i = 0; i < 64; ++i) { umx = uk[i] > umx ? uk[i] : umx; const int v = uk[i] == PAD ? 0x7FFFFFFF : uk[i]; umn = v < umn ? v : umn; }
#pragma unroll
                    for (int o = 1; o < 64; o <<= 1) { const int a = __shfl_xor(umx, o), c = __shfl_xor(umn, o); umx = a > umx ? a : umx; umn = c < umn ? c : umn; }
                    int lo_ = umn, hi_ = umx; bool fl = true;
                    while (lo_ < hi_) {
                        int mid = lo_ + (int)(((unsigned)hi_ - (unsigned)lo_) >> 1) + 1;
                        if (fl) {
                            const float lf = __int_as_float(lo_ >= 0 ? lo_ : (lo_ ^ 0x7FFFFFFF)), hf = __int_as_float(hi_ >= 0 ? hi_ : (hi_ ^ 0x7FFFFFFF));
                            const int x = __float_as_int(0.5f * lf + 0.5f * hf); const int um = x >= 0 ? x : (x ^ 0x7FFFFFFF);
                            if (um > lo_ && um <= hi_) mid = um; else fl = false;
                        }
                        int c; CNT_GE(c, mid);
                        if (c == 256) { lo_ = mid - 1; hi_ = mid - 1; break; }
                        if (c > 256) lo_ = mid; else hi_ = mid - 1;
                    }
                    Tk = lo_;
                    int cge, cgt; CNT_GE(cge, Tk); if (Tk == 0x7FFFFFFF) cgt = 0; else CNT_GE(cgt, Tk + 1);
                    r = 256 - cgt; ceq = cge - cgt;
                }
#undef CNT_GE
                int nb = 0;
                if (r == 0 || r == ceq) {
                    const int thr = (r == 0) ? ((Tk == 0x7FFFFFFF) ? Tk : Tk + 1) : Tk;
                    const bool none = (r == 0) && (Tk == 0x7FFFFFFF);
                    int cnt = 0;
#pragma unroll
                    for (int i = 0; i < 64; ++i) cnt += (!none && uk[i] >= thr) ? 1 : 0;
                    int incl = cnt;
#pragma unroll
                    for (int o = 1; o < 64; o <<= 1) { const int v = __shfl_up(incl, o); if (lane >= o) incl += v; }
                    int pos = incl - cnt; nb = __shfl(incl, 63);
#pragma unroll
                    for (int i = 0; i < 64; ++i) { if (!none && uk[i] >= thr) { const int sk = 256 * (i >> 2) + 4 * lane + (i & 3); lq[pos] = (unsigned)sk; ++pos; } }
                } else {
                    int eb = 0;
#pragma unroll
                    for (int j = 0; j < 16; ++j) {
                        if (256 * j <= t) {
                            bool gt[4], eq[4], sel[4]; int leq = 0, teq = 0;
#pragma unroll
                            for (int e = 0; e < 4; ++e) { gt[e] = uk[4 * j + e] > Tk; eq[e] = uk[4 * j + e] == Tk; const unsigned long long me = __ballot(eq[e]);
                                leq += (int)__builtin_amdgcn_mbcnt_hi((unsigned)(me >> 32), __builtin_amdgcn_mbcnt_lo((unsigned)me, 0u)); teq += __popcll(me); }
                            int run = eb + leq, lsel = 0, tsel = 0;
#pragma unroll
                            for (int e = 0; e < 4; ++e) { sel[e] = gt[e] || (eq[e] && run < r); run += eq[e] ? 1 : 0; const unsigned long long ms = __ballot(sel[e]);
                                lsel += (int)__builtin_amdgcn_mbcnt_hi((unsigned)(ms >> 32), __builtin_amdgcn_mbcnt_lo((unsigned)ms, 0u)); tsel += __popcll(ms); }
                            int pos = nb + lsel;
#pragma unroll
                            for (int e = 0; e < 4; ++e) { if (sel[e]) { const int sk = 256 * j + 4 * lane + e; lq[pos] = (unsigned)sk; ++pos; } }
                            nb += tsel; eb += teq;
                            asm volatile("" : "+s"(nb), "+s"(eb));
                        }
                    }
                }
                LDS_WAIT();
                { const int nchq = (nb + 31) >> 5; if (lane < nchq * 32 - nb) lq[nb + lane] = 0u; }
                if (qq == 0) n0 = nb; else n1 = nb;
            }
            LDS_WAIT();
            {
                const int nch0 = (n0 + 31) >> 5, ntot = nch0 + ((n1 + 31) >> 5);
                const f16* cbase = CKV + (size_t)b * SEQ * 128;
#define AT_GATHER(g_) do { const int qq_ = (g_) >= nch0 ? 1 : 0; const LAS unsigned* lq_ = lst + qq_ * 256 + ((g_) - (qq_ ? nch0 : 0)) * 32; LAS unsigned char* dst_ = cbuf + ((g_) & 1) * 8192; \
                    _Pragma("unroll") for (int i_ = 0; i_ < 8; ++i_) { const unsigned en_ = lq_[4 * i_ + fg]; const unsigned sw_ = (unsigned)((fg << 2) | (i_ & 3)); \
                    __builtin_amdgcn_global_load_lds((const unsigned*)(cbase + (size_t)en_ * 128 + 8 * (fr ^ sw_)), (LAS unsigned*)(dst_ + i_ * 1024), 16, 0, 0); } } while (0)
                AT_GATHER(0);
                f32x4 O[8]; f16x8 qB[4]; float m_run = 0.f, l_run = 0.f;
#pragma unroll
                for (int c = 0; c < 8; ++c) O[c] = (f32x4){0.f, 0.f, 0.f, 0.f};
#pragma unroll
                for (int ks = 0; ks < 4; ++ks) qB[ks] = (f16x8){0, 0, 0, 0, 0, 0, 0, 0};
                for (int g = 0; g < ntot; ++g) {
                    const int qq = g >= nch0 ? 1 : 0, ci = g - (qq ? nch0 : 0), nsel = qq ? n1 : n0, nchq = (nsel + 31) >> 5;
                    const size_t q = (size_t)(q0 + 2 * wave + qq); const int tq = 16 * qt + 2 * wave + qq;
                    const LAS unsigned* lq = lst + qq * 256;
                    if (ci == 0) {
#pragma unroll
                        for (int c = 0; c < 8; ++c) O[c] = (f32x4){0.f, 0.f, 0.f, 0.f};
                        m_run = -__builtin_inff(); l_run = 0.f;
                        if (fr < 8) {
#pragma unroll
                            for (int ks = 0; ks < 4; ++ks) qB[ks] = *(const f16x8*)(QLAT + q * 1024 + fr * 128 + 32 * ks + 8 * fg); }
                    }
                    LDS_WAIT();
                    if (g + 1 < ntot) { AT_GATHER(g + 1); asm volatile("s_waitcnt vmcnt(8)" ::: "memory"); } else { asm volatile("s_waitcnt vmcnt(0)" ::: "memory"); }
                    const LAS unsigned char* buf = cbuf + (g & 1) * 8192;
                    f32x4 d0 = {0.f, 0.f, 0.f, 0.f}, d1 = d0;
#pragma unroll
                    for (int ks = 0; ks < 4; ++ks) {
                        const f16x8 a0 = *(const LAS f16x8*)(buf + off_b(8 * q_ + p_, 4 * ks + fg)), a1 = *(const LAS f16x8*)(buf + off_b(8 * q_ + 4 + p_, 4 * ks + fg));
                        d0 = __builtin_amdgcn_mfma_f32_16x16x32_f16(a0, qB[ks], d0, 0, 0, 0);
                        d1 = __builtin_amdgcn_mfma_f32_16x16x32_f16(a1, qB[ks], d1, 0, 0, 0);
                    }
                    const u32x4 e0 = *(const LAS u32x4*)(lq + ci * 32 + 8 * fg), e1 = *(const LAS u32x4*)(lq + ci * 32 + 8 * fg + 4);
                    float lg[8];
#pragma unroll
                    for (int r = 0; r < 4; ++r) {
                        int da = tq - (int)e0[r], db = tq - (int)e1[r]; da = da < 0 ? 0 : (da > 127 ? 127 : da); db = db < 0 ? 0 : (db > 127 ? 127 : db);
                        lg[r] = (ci * 32 + 8 * fg + r < nsel) ? d0[r] * 0.125f + relb[bkt[da] * 16 + fr] : -__builtin_inff();
                        lg[4 + r] = (ci * 32 + 8 * fg + 4 + r < nsel) ? d1[r] * 0.125f + relb[bkt[db] * 16 + fr] : -__builtin_inff();
                    }
                    float mx = fmaxf(fmaxf(fmaxf(lg[0], lg[1]), fmaxf(lg[2], lg[3])), fmaxf(fmaxf(lg[4], lg[5]), fmaxf(lg[6], lg[7])));
                    mx = fmaxf(mx, __shfl_xor(mx, 16)); mx = fmaxf(mx, __shfl_xor(mx, 32));
                    const float m_new = fmaxf(m_run, mx);
                    const float alpha = __expf(m_run - m_new);
                    m_run = m_new;
                    float pr[8], ps = 0.f;
#pragma unroll
                    for (int r = 0; r < 8; ++r) { pr[r] = __expf(lg[r] - m_new); ps += pr[r]; }
                    l_run = l_run * alpha + ps;
                    f16x8 pa;
#pragma unroll
                    for (int r = 0; r < 8; ++r) pa[r] = (f16)pr[r];
                    float al[4];
#pragma unroll
                    for (int r = 0; r < 4; ++r) al[r] = __shfl(alpha, 4 * fg + r);
#pragma unroll
                    for (int c = 0; c < 8; ++c) {
#pragma unroll
                        for (int r = 0; r < 4; ++r) O[c][r] *= al[r];
                        const s16x4 t0 = lds_tr16(buf + off_b(8 * fg + q_, 2 * c + (p_ >> 1)) + 8 * (p_ & 1)), t1 = lds_tr16(buf + off_b(8 * fg + 4 + q_, 2 * c + (p_ >> 1)) + 8 * (p_ & 1));
                        O[c] = __builtin_amdgcn_mfma_f32_16x16x32_f16(pa, __builtin_bit_cast(f16x8, cat44(t0, t1)), O[c], 0, 0, 0);
                    }
                    if (ci == nchq - 1) {
                        float lt = l_run; lt += __shfl_xor(lt, 16); lt += __shfl_xor(lt, 32);
                        const float inv = 1.0f / lt;
                        float iv[4];
#pragma unroll
                        for (int r = 0; r < 4; ++r) iv[r] = __shfl(inv, 4 * fg + r);
                        if (fg < 2) {
#pragma unroll
                            for (int c = 0; c < 8; ++c)
#pragma unroll
                                for (int r = 0; r < 4; ++r) QLAT[q * 1024 + (4 * fg + r) * 128 + 16 * c + fr] = (f16)(O[c][r] * iv[r]);
                        }
                    }
                }
#undef AT_GATHER
                LDS_WAIT();
            }
            __syncthreads();
        }
    }
    SEAM(7);
    if (IN(8)) for (int rep_ = 0; rep_ < REPS(8); ++rep_) { PH_BEGIN(); pg8::Gemm g{XN, (const f16*)(ws + W_G), M, NGATE, DM}; pg8::StaticOrder S; S.init(M, NGATE, G, bx);
        pg8::Epi<pg8::EP_GATES> E{}; E.O = GT; E.ldc = NGATE; E.bias = args.in[19]; pg8::gemm_phase(lds, g, S, E); }
    SEAM(8);
    if (IN(9)) for (int rep_ = 0; rep_ < REPS(9); ++rep_) { PH_BEGIN(); pg8::Gemm g{QLAT, (const f16*)(ws + W_UVBR), M, DM, DM}; pg8::StaticOrder S; S.init(M, DM, G, bx);
        pg8::Epi<pg8::EP_BRA> E{}; E.O = MERGED; E.ldc = DM; E.Gt = GT; pg8::gemm_phase(lds, g, S, E); }
    if (IN(10)) for (int rep_ = 0; rep_ < REPS(10); ++rep_) { PH_BEGIN(); pg8::Gemm g{YB, (const f16*)(ws + W_BRB), M, DM, 512}; pg8::StaticOrder S; S.init(M, DM, G, bx);
        pg8::Epi<pg8::EP_BRB> E{}; E.O = MERGED; E.ldc = DM; E.Gt = GT; pg8::gemm_phase(lds, g, S, E); }
    SEAM(10);
    if (IN(11)) for (int rep_ = 0; rep_ < REPS(11); ++rep_) { PH_BEGIN(); pg8::Gemm g{MERGED, (const f16*)(ws + W_OUT), M, DM, DM}; pg8::StaticOrder S; S.init(M, DM, G, bx);
        pg8::Epi<pg8::EP_F16> E{}; E.O = Y; E.ldc = DM; pg8::gemm_phase(lds, g, S, E); }
    SEAM(11);
    if (IN(12)) for (int rep_ = 0; rep_ < REPS(12); ++rep_) { PH_BEGIN(); for (int m = gw; m < M; m += NGW) row_update(HOUT + (size_t)m * DM, Y + (size_t)m * DM, args.in[10], 1.0f, HOUT + (size_t)m * DM, args.in[21], XN + (size_t)m * DM, lane); }
    SEAM(12);
    if (IN(13)) for (int rep_ = 0; rep_ < REPS(13); ++rep_) { PH_BEGIN(); pg8::Gemm g{XN, (const f16*)(ws + W_GU2), M, 2 * FF, DM}; pg8::StaticOrder S; S.init(M, 2 * FF, G, bx);
        pg8::Epi<pg8::EP_SWIGLU> E{}; E.O = ACT; E.ldc = FF; pg8::gemm_phase(lds, g, S, E); }
    SEAM(13);
    if (IN(14)) for (int rep_ = 0; rep_ < REPS(14); ++rep_) { PH_BEGIN(); pg8::Gemm g{ACT, (const f16*)(ws + W_D2), M, DM, FF}; pg8::StaticOrder S; S.init(M, DM, G, bx);
        pg8::Epi<pg8::EP_F16> E{}; E.O = Y; E.ldc = DM; pg8::gemm_phase(lds, g, S, E); }
    SEAM(14);
    if (IN(15)) for (int rep_ = 0; rep_ < REPS(15); ++rep_) { PH_BEGIN(); for (int m = gw; m < M; m += NGW) row_update(HOUT + (size_t)m * DM, Y + (size_t)m * DM, args.in[22], 0.5f, HOUT + (size_t)m * DM, args.in[26], XN + (size_t)m * DM, lane); }
    SEAM(15);
    if (IN(16)) for (int rep_ = 0; rep_ < REPS(16); ++rep_) { PH_BEGIN(); pg8::Gemm g{XN, (const f16*)(ws + W_PG), M, DM, DM}; pg8::StaticOrder S; S.init(M, DM, G, bx);
        pg8::Epi<pg8::EP_PLE1> E{}; E.O = GP; E.ldc = DM; pg8::gemm_phase(lds, g, S, E); }
    if (IN(17)) for (int rep_ = 0; rep_ < REPS(17); ++rep_) { PH_BEGIN(); pg8::Gemm g{P16, (const f16*)(ws + W_PP), M, DM, PLE}; pg8::StaticOrder S; S.init(M, DM, G, bx);
        pg8::Epi<pg8::EP_PLE2> E{}; E.O = Y; E.ldc = DM; E.Gt = GP; pg8::gemm_phase(lds, g, S, E); }
    SEAM(17);
    if (IN(18)) for (int rep_ = 0; rep_ < REPS(18); ++rep_) { PH_BEGIN(); for (int m = gw; m < M; m += NGW) row_update(HOUT + (size_t)m * DM, Y + (size_t)m * DM, args.in[27], 1.0f, HOUT + (size_t)m * DM, nullptr, nullptr, lane); }
#undef IN
#undef SEAM
#undef PH_BEGIN
}

extern "C" void kernel_launch(void* const* d_in, const int* in_sizes, int n_in, void* d_out, int out_size, void* d_ws, size_t ws_size, hipStream_t stream) {
    static int grid = 0;
    if (grid == 0) {
        if (n_in != 30 || in_sizes[0] != M * DM || out_size != M * DM || ws_size < WS_END) {
            fprintf(stderr, "kernel_launch: unexpected shapes/workspace (n_in %d, in0 %d, out %d, ws %zu)\n", n_in, n_in > 0 ? in_sizes[0] : -1, out_size, ws_size); grid = -1; return; }
        int dev = 0, cus = 0;
        if (hipGetDevice(&dev) != hipSuccess || hipDeviceGetAttribute(&cus, hipDeviceAttributeMultiprocessorCount, dev) != hipSuccess) { grid = -1; return; }
        if (hipFuncSetAttribute((const void*)mk_fwd, hipFuncAttributeMaxDynamicSharedMemorySize, LDS_BYTES) != hipSuccess) { fprintf(stderr, "kernel_launch: hipFuncSetAttribute failed\n"); grid = -1; return; }
        (void)hipGetLastError();
        grid = cus;
    }
    if (grid < 0) return;
    (void)hipMemsetAsync((char*)d_ws + WS_CTL, 0, CTL_ZERO_BYTES, stream);
    Args a{};
    for (int i = 0; i < 30; ++i) a.in[i] = (const float*)d_in[i];
    a.out = (float*)d_out; a.ws = (unsigned char*)d_ws;
#if MK_PER_PHASE_LAUNCH
    for (int ph = 0; ph < NPHASE; ++ph) { a.ph_lo = ph; a.ph_hi = ph + 1; hipLaunchKernelGGL(mk_fwd, dim3(grid), dim3(NTHREADS), LDS_BYTES, stream, a); }
#else
    a.ph_lo = 0; a.ph_hi = NPHASE; hipLaunchKernelGGL(mk_fwd, dim3(grid), dim3(NTHREADS), LDS_BYTES, stream, a);
#endif
}
```

```cpp
#include <hip/hip_runtime.h>
#include <cstdio>
#include <cstdint>

#ifndef MK_PER_PHASE_LAUNCH
#define MK_PER_PHASE_LAUNCH 0
#endif

#define LAS __attribute__((address_space(3)))
#define GAS __attribute__((address_space(1)))
typedef _Float16 f16;
typedef _Float16 f16x2 __attribute__((ext_vector_type(2)));
typedef _Float16 f16x4 __attribute__((ext_vector_type(4)));
typedef _Float16 f16x8 __attribute__((ext_vector_type(8)));
typedef float f32x2 __attribute__((ext_vector_type(2)));
typedef float f32x4 __attribute__((ext_vector_type(4)));
typedef unsigned u32x4 __attribute__((ext_vector_type(4)));

constexpr int BATCH = 8, SEQ = 4096, DM = 1024, FF = 2816, M = BATCH * SEQ, PLE = 256;
constexpr int NIN = 3840;
constexpr int NGATE = 2048;
constexpr float EPS = 1e-6f;
constexpr int NWAVES = 8, NTHREADS = 512;
constexpr int NPHASE = 19;

constexpr size_t MiB = 1u << 20;
constexpr size_t WS_CTL = 0, CTL_ZERO_BYTES = 1 * MiB;
constexpr size_t WS_W = 1 * MiB;
constexpr size_t W_GU1 = WS_W, W_D1 = W_GU1 + 11 * MiB, W_IN = W_D1 + 11 * MiB / 2, W_G = W_IN + 15 * MiB / 2, W_BRB = W_G + 4 * MiB,
                 W_UVBR = W_BRB + 1 * MiB, W_OUT = W_UVBR + 2 * MiB, W_GU2 = W_OUT + 2 * MiB, W_D2 = W_GU2 + 11 * MiB, W_PG = W_D2 + 11 * MiB / 2,
                 W_PP = W_PG + 2 * MiB, W_LB = W_PP + MiB / 2;
static_assert(W_LB + 4096 <= 54 * MiB, "weights region");
constexpr size_t WS_XN = 54 * MiB, WS_Y = 118 * MiB, WS_OH = 118 * MiB, WS_YB = 150 * MiB, WS_ACT = 182 * MiB;
constexpr size_t WS_QLAT = 182 * MiB, WS_QIDX = 246 * MiB, WS_QH = 278 * MiB, WS_IH = 310 * MiB, WS_GH = 342 * MiB, WS_LOGF = 374 * MiB,
                 WS_SMALL = 438 * MiB, WS_CKV = 470 * MiB, WS_KIDX = 478 * MiB, WS_WQ = 482 * MiB, WS_P16 = 483 * MiB;
constexpr size_t WS_G = 246 * MiB, WS_MERGED = 374 * MiB, WS_GP = 358 * MiB, WS_END = 512 * MiB;
constexpr int CW_BAR = 4096;

constexpr int RING_BYTES = 131072, WSM_OFF = 131072, WSM_BYTES = 2560, TAB_OFF = WSM_OFF + 8 * WSM_BYTES, LDSCTL_OFF = TAB_OFF + 3072, LDS_BYTES = 160 * 1024;
static_assert(LDSCTL_OFF + 512 <= LDS_BYTES, "LDS map");

struct Args { const float* in[30]; float* out; unsigned char* ws; int ph_lo, ph_hi; };

__device__ __forceinline__ float wave_sum(float v) {
#pragma unroll
    for (int o = 1; o < 64; o <<= 1) v += __shfl_xor(v, o);
    return v;
}
__device__ __forceinline__ float wave_max(float v) {
#pragma unroll
    for (int o = 1; o < 64; o <<= 1) v = fmaxf(v, __shfl_xor(v, o));
    return v;
}
__device__ __forceinline__ float sigmoidf_(float x) { return __builtin_amdgcn_rcpf(1.0f + __expf(-x)); }
__device__ __forceinline__ float siluf_(float x) { return x * sigmoidf_(x); }
__device__ __forceinline__ float dot8(f16x8 a, f16x8 b, float c) {
    c = __builtin_amdgcn_fdot2(__builtin_shufflevector(a, a, 0, 1), __builtin_shufflevector(b, b, 0, 1), c, false);
    c = __builtin_amdgcn_fdot2(__builtin_shufflevector(a, a, 2, 3), __builtin_shufflevector(b, b, 2, 3), c, false);
    c = __builtin_amdgcn_fdot2(__builtin_shufflevector(a, a, 4, 5), __builtin_shufflevector(b, b, 4, 5), c, false);
    c = __builtin_amdgcn_fdot2(__builtin_shufflevector(a, a, 6, 7), __builtin_shufflevector(b, b, 6, 7), c, false);
    return c;
}

typedef short bf16x8 __attribute__((ext_vector_type(8)));
typedef short s16x4 __attribute__((ext_vector_type(4)));
typedef __bf16 bf16x2_t __attribute__((ext_vector_type(2)));
__device__ __forceinline__ unsigned pk_bf16(float lo, float hi) { f32x2 v = {lo, hi}; bf16x2_t b = __builtin_convertvector(v, bf16x2_t); return __builtin_bit_cast(unsigned, b); }
__device__ __forceinline__ s16x4 lds_tr16(const LAS unsigned char* p) { return __builtin_bit_cast(s16x4, __builtin_amdgcn_ds_read_tr16_b64_v4i16((LAS s16x4*)p)); }
__device__ __forceinline__ bf16x8 cat44(s16x4 a, s16x4 b) { return __builtin_shufflevector(a, b, 0, 1, 2, 3, 4, 5, 6, 7); }
__device__ __forceinline__ bf16x8 pack_bf8(f32x4 a, f32x4 b) { u32x4 w; w[0] = pk_bf16(a[0], a[1]); w[1] = pk_bf16(a[2], a[3]); w[2] = pk_bf16(b[0], b[1]); w[3] = pk_bf16(b[2], b[3]); return __builtin_bit_cast(bf16x8, w); }
__device__ __forceinline__ unsigned off_b(unsigned row, unsigned ch) { return 256u * row + 16u * (ch ^ (((row & 3u) << 2) | ((row >> 2) & 3u))); }
#define LDS_WAIT() asm volatile("s_waitcnt lgkmcnt(0)" ::: "memory")
#define VM_WAIT() asm volatile("s_waitcnt vmcnt(0)" ::: "memory")

namespace pg8 {
constexpr int BM = 256, BK = 64, HALF = 128, HTB = HALF * BK * 2, STAGE_BYTES = 8 * HTB, NXCD = 8, WGM = 8;
__host__ __device__ __forceinline__ int lds_byte(int r, int c) { const int st = (r >> 4) * 2 + (c >> 5), rr = r & 15, cc = c & 31, ob = rr * 64 + cc * 2; return st * 1024 + (ob ^ (((ob >> 9) & 1) << 5)); }
__host__ __device__ __forceinline__ void stage_rc(int b, int& R, int& C) { const int st = b / 1024, sb = b % 1024, swz = sb ^ (((sb >> 9) & 1) << 5); R = (st >> 1) * 16 + swz / 64; C = (st & 1) * 32 + (swz % 64) / 2; }
__host__ __device__ __forceinline__ int perm32(int rho) { const int n = rho >> 4, i = rho & 15; return 8 * (i >> 2) + 4 * n + (i & 3); }
struct Unit { int pm, pn; };
struct Gemm { const f16* A; const f16* Bt; int M, N, K; };
struct StaticOrder {
    int nM, nN, nwg, G, c;
    __device__ void init(int M_, int N_, int G_, int c_) { nM = M_ / BM; nN = N_ / BM; nwg = nM * nN; G = G_; c = c_; }
    __device__ bool next(int i, Unit& u) const {
        const long L = (long)i * G + c; if (L >= nwg) return false;
        int wgid = (int)L; { const int q = nwg / NXCD, r = nwg % NXCD, xcd = wgid % NXCD, off = wgid / NXCD; wgid = (xcd < r ? xcd * (q + 1) : r * (q + 1) + (xcd - r) * q) + off; }
        const int nig = WGM * nN, gid = wgid / nig, fm = gid * WGM, gsz = (nM - fm) < WGM ? (nM - fm) : WGM;
        u.pm = fm + ((wgid % nig) % gsz); u.pn = (wgid % nig) / gsz; return true;
    }
};

enum { EP_SWIGLU = 0, EP_F16 = 1, EP_INPROJ = 2, EP_GATES = 3, EP_BRA = 4, EP_BRB = 5, EP_PLE1 = 6, EP_PLE2 = 7 };
__device__ __forceinline__ f16x8 pack8(f32x4 a, f32x4 b) { f16x8 w; w[0] = (f16)a[0]; w[1] = (f16)a[1]; w[2] = (f16)a[2]; w[3] = (f16)a[3]; w[4] = (f16)b[0]; w[5] = (f16)b[1]; w[6] = (f16)b[2]; w[7] = (f16)b[3]; return w; }
template <int MODE> struct Epi {
    f16* O; int ldc; const f16* Gt; const float* bias;
    f16 *qlat, *qidx, *qh, *ih, *gh; float *logf, *small; const float* lb;
    __device__ __forceinline__ void operator()(const f32x4 (&acc)[2][2][4][2], const Unit& u, int wr, int wc, int fr, int fq) const {
        const int row0 = u.pm * BM + wr * 64 + fr;
        if constexpr (MODE == EP_SWIGLU) {
            const int col = u.pn * 128 + wc * 32 + 8 * fq;
#pragma unroll
            for (int ai = 0; ai < 2; ++ai)
#pragma unroll
                for (int m = 0; m < 4; ++m) { const size_t row = row0 + ai * HALF + m * 16; f32x4 v[2];
#pragma unroll
                    for (int n = 0; n < 2; ++n)
#pragma unroll
                        for (int j = 0; j < 4; ++j) v[n][j] = siluf_(acc[ai][0][m][n][j]) * acc[ai][1][m][n][j];
                    *(f16x8*)(O + row * ldc + col) = pack8(v[0], v[1]); }
        } else {
            const int colb = u.pn * BM + wc * 32 + 8 * fq;
            f32x4 bv[2][2] = {{{0.f, 0.f, 0.f, 0.f}, {0.f, 0.f, 0.f, 0.f}}, {{0.f, 0.f, 0.f, 0.f}, {0.f, 0.f, 0.f, 0.f}}};
            if constexpr (MODE == EP_GATES) {
#pragma unroll
                for (int bj = 0; bj < 2; ++bj) { bv[bj][0] = *(const f32x4*)(bias + colb + bj * HALF); bv[bj][1] = *(const f32x4*)(bias + colb + bj * HALF + 4); } }
            if constexpr (MODE == EP_INPROJ) { if (u.pn == 8 || u.pn == 9) {
#pragma unroll
                for (int bj = 0; bj < 2; ++bj) { bv[bj][0] = *(const f32x4*)(lb + colb + bj * HALF - 2048); bv[bj][1] = *(const f32x4*)(lb + colb + bj * HALF - 2048 + 4); } } }
#pragma unroll
            for (int ai = 0; ai < 2; ++ai)
#pragma unroll
                for (int m = 0; m < 4; ++m) { const size_t row = row0 + ai * HALF + m * 16;
#pragma unroll
                    for (int bj = 0; bj < 2; ++bj) { const int col = colb + bj * HALF; f32x4 v0 = acc[ai][bj][m][0], v1 = acc[ai][bj][m][1];
                        if constexpr (MODE == EP_F16) { *(f16x8*)(O + row * ldc + col) = pack8(v0, v1); }
                        if constexpr (MODE == EP_GATES || MODE == EP_PLE1) {
#pragma unroll
                            for (int j = 0; j < 4; ++j) { v0[j] = sigmoidf_(v0[j] + bv[bj][0][j]); v1[j] = sigmoidf_(v1[j] + bv[bj][1][j]); }
                            *(f16x8*)(O + row * ldc + col) = pack8(v0, v1); }
                        if constexpr (MODE == EP_BRA || MODE == EP_BRB || MODE == EP_PLE2) {
                            const f16x8 g = *(const f16x8*)(Gt + row * (MODE == EP_PLE2 ? 1024 : 2048) + (MODE == EP_BRB ? 1024 : 0) + col);
#pragma unroll
                            for (int j = 0; j < 4; ++j) { v0[j] *= (float)g[j]; v1[j] *= (float)g[4 + j]; }
                            if constexpr (MODE == EP_BRB) { const f16x8 o = *(const f16x8*)(O + row * ldc + col);
#pragma unroll
                                for (int j = 0; j < 4; ++j) { v0[j] += (float)o[j]; v1[j] += (float)o[4 + j]; } }
                            *(f16x8*)(O + row * ldc + col) = pack8(v0, v1); }
                        if constexpr (MODE == EP_INPROJ) {
                            const int pn = u.pn;
                            if (pn < 4) { *(f16x8*)(qlat + row * 1024 + col) = pack8(v0, v1); }
                            else if (pn < 6) { *(f16x8*)(qidx + row * 512 + (col - 1024)) = pack8(v0, v1); }
                            else if (pn < 8) {
#pragma unroll
                                for (int j = 0; j < 4; ++j) { v0[j] = siluf_(v0[j]); v1[j] = siluf_(v1[j]); }
                                *(f16x8*)(qh + row * 512 + (col - 1536)) = pack8(v0, v1); }
                            else if (pn < 10) {
#pragma unroll
                                for (int j = 0; j < 4; ++j) { v0[j] = __logf(bv[bj][0][j] + (1.0f - bv[bj][0][j]) * sigmoidf_(v0[j])); v1[j] = __logf(bv[bj][1][j] + (1.0f - bv[bj][1][j]) * sigmoidf_(v1[j])); }
                                *(f32x4*)(logf + row * 512 + (col - 2048)) = v0; *(f32x4*)(logf + row * 512 + (col - 2048) + 4) = v1; }
                            else if (pn < 12) { *(f16x8*)(ih + row * 512 + (col - 2560)) = pack8(v0, v1); }
                            else if (pn < 14) {
#pragma unroll
                                for (int j = 0; j < 4; ++j) { v0[j] = siluf_(v0[j]); v1[j] = siluf_(v1[j]); }
                                *(f16x8*)(gh + row * 512 + (col - 3072)) = pack8(v0, v1); }
                            else { *(f32x4*)(small + row * 256 + (col - 3584)) = v0; *(f32x4*)(small + row * 256 + (col - 3584) + 4) = v1; }
                        }
                    }
                    if constexpr (MODE == EP_BRA || MODE == EP_BRB || MODE == EP_PLE2) asm volatile("" ::: "memory");
                }
        }
    }
};

template <class EpiT>
__device__ __forceinline__ void gemm_phase(LAS unsigned char* lds, const Gemm g, const StaticOrder& S, const EpiT& E) {
    const int tid = threadIdx.x, wid = __builtin_amdgcn_readfirstlane(tid >> 6), lane = tid & 63, wr = wid >> 2, wc = wid & 3, fr = lane & 15, fq = lane >> 4;
    const int K = g.K, nt = K / BK;
    unsigned voffA[2], voffB[2];
#pragma unroll
    for (int i = 0; i < 2; ++i) { int R, C; stage_rc(tid * 16 + i * 8192, R, C); const int Rb = (R & ~31) + perm32(R & 31);
        voffA[i] = (unsigned)(R * K + C) * 2u; voffB[i] = (unsigned)(Rb * K + C) * 2u; }
    const size_t kstep = (size_t)(BK * 2);
    const size_t hstep = (size_t)HALF * K * 2;
    const size_t tstep = 2 * hstep;
    const unsigned ldsw = (unsigned)wid * 1024u;
    const int aoff = lds_byte(wr * 64 + fr, fq * 8), boff = lds_byte(wc * 32 + fr, fq * 8);
#define PG8_SA(b, h) (((b) * 2 + (h)) * HTB)
#define PG8_SB(b, h) ((4 + (b) * 2 + (h)) * HTB)
#define PG8_STAGE(bufoff, gbase, voff) do { _Pragma("unroll") for (int _i = 0; _i < 2; ++_i) \
        __builtin_amdgcn_global_load_lds((const unsigned*)((const char*)(gbase) + (voff)[_i]), (LAS unsigned*)(lds + (bufoff) + ldsw + _i * 8192), 16, 0, 0); } while (0)
#define PG8_LDA(dst, b, h) do { _Pragma("unroll") for (int m = 0; m < 4; ++m) _Pragma("unroll") for (int k = 0; k < 2; ++k) dst[m][k] = *(const LAS f16x8*)(lds + PG8_SA(b, h) + aoff + m * 2048 + k * 1024); } while (0)
#define PG8_LDB(dst, b, h) do { _Pragma("unroll") for (int n = 0; n < 2; ++n) _Pragma("unroll") for (int k = 0; k < 2; ++k) dst[n][k] = *(const LAS f16x8*)(lds + PG8_SB(b, h) + boff + n * 2048 + k * 1024); } while (0)
#define PG8_MMA(ai, bj, At, Bt) do { __builtin_amdgcn_s_setprio(1); _Pragma("unroll") for (int m = 0; m < 4; ++m) _Pragma("unroll") for (int n = 0; n < 2; ++n) _Pragma("unroll") for (int k = 0; k < 2; ++k) \
        acc[ai][bj][m][n] = __builtin_amdgcn_mfma_f32_16x16x32_f16(Bt[n][k], At[m][k], acc[ai][bj][m][n], 0, 0, 0); __builtin_amdgcn_s_setprio(0); } while (0)
#define PG8_WAIT_V(n) asm volatile("s_waitcnt vmcnt(" #n ")" ::: "memory")
#define PG8_WAIT_L(n) asm volatile("s_waitcnt lgkmcnt(" #n ")" ::: "memory")
#define PG8_BAR __builtin_amdgcn_s_barrier()
#define PG8_SCHED __builtin_amdgcn_sched_barrier(0)
    Unit cur, nxt; int ui = 0;
    if (!S.next(0, cur)) return;
    f32x4 acc[2][2][4][2];
#pragma unroll
    for (int a = 0; a < 2; ++a)
#pragma unroll
        for (int b = 0; b < 2; ++b)
#pragma unroll
            for (int m = 0; m < 4; ++m)
#pragma unroll
                for (int n = 0; n < 2; ++n) acc[a][b][m][n] = (f32x4){0.f, 0.f, 0.f, 0.f};
    f16x8 At[4][2], B0[2][2], B1[2][2];
    const char* cA = (const char*)g.A + (size_t)cur.pm * tstep; const char* cB = (const char*)g.Bt + (size_t)cur.pn * tstep;
    PG8_STAGE(PG8_SB(0, 0), cB, voffB); PG8_STAGE(PG8_SB(0, 1), cB + hstep, voffB); PG8_STAGE(PG8_SA(0, 0), cA, voffA); PG8_STAGE(PG8_SA(0, 1), cA + hstep, voffA);
    if (wr == 1) PG8_BAR;
    PG8_WAIT_V(2); PG8_BAR;
    PG8_STAGE(PG8_SB(1, 0), cB + kstep, voffB); PG8_STAGE(PG8_SA(1, 0), cA + kstep, voffA); PG8_STAGE(PG8_SB(1, 1), cB + hstep + kstep, voffB);
    PG8_WAIT_V(6); PG8_BAR;
    for (;;) {
        const bool has_next = S.next(ui + 1, nxt);
        const char* nA = has_next ? (const char*)g.A + (size_t)nxt.pm * tstep : cA; const char* nB = has_next ? (const char*)g.Bt + (size_t)nxt.pn * tstep : cB;
        for (int t = 0; t < nt; t += 2) {
            const bool last = (t == nt - 2);
            const char* a1 = cA + (size_t)(t + 1) * kstep;
            const char* a2 = last ? nA : cA + (size_t)(t + 2) * kstep; const char* b2 = last ? nB : cB + (size_t)(t + 2) * kstep;
            const char* a3 = a2 + kstep; const char* b3 = b2 + kstep;
            PG8_LDB(B0, 0, 0); PG8_LDB(B1, 0, 1); PG8_SCHED; PG8_LDA(At, 0, 0); PG8_STAGE(PG8_SA(1, 1), a1 + hstep, voffA);
            PG8_WAIT_V(8); PG8_WAIT_L(0); PG8_BAR; PG8_MMA(0, 0, At, B0); PG8_MMA(0, 1, At, B1); PG8_BAR; PG8_SCHED;
            PG8_LDA(At, 0, 1); PG8_STAGE(PG8_SB(0, 0), b2, voffB); PG8_STAGE(PG8_SB(0, 1), b2 + hstep, voffB); PG8_STAGE(PG8_SA(0, 0), a2, voffA);
            PG8_WAIT_V(8); PG8_WAIT_L(0); PG8_BAR; PG8_MMA(1, 0, At, B0); PG8_MMA(1, 1, At, B1); PG8_BAR; PG8_SCHED;
            PG8_LDB(B0, 1, 0); PG8_LDB(B1, 1, 1); PG8_SCHED; PG8_LDA(At, 1, 0); PG8_STAGE(PG8_SA(0, 1), a2 + hstep, voffA);
            PG8_WAIT_V(8); PG8_WAIT_L(0); PG8_BAR; PG8_MMA(0, 0, At, B0); PG8_MMA(0, 1, At, B1); PG8_BAR; PG8_SCHED;
            PG8_LDA(At, 1, 1); PG8_STAGE(PG8_SB(1, 0), b3, voffB); PG8_STAGE(PG8_SB(1, 1), b3 + hstep, voffB); PG8_STAGE(PG8_SA(1, 0), a3, voffA);
            PG8_WAIT_V(8); PG8_WAIT_L(0); PG8_BAR; PG8_MMA(1, 0, At, B0); PG8_MMA(1, 1, At, B1); PG8_BAR; PG8_SCHED;
        }
        if (wr == 0) PG8_BAR;
        E(acc, cur, wr, wc, fr, fq);
        if (!has_next) break;
#pragma unroll
        for (int a = 0; a < 2; ++a)
#pragma unroll
            for (int b = 0; b < 2; ++b)
#pragma unroll
                for (int m = 0; m < 4; ++m)
#pragma unroll
                    for (int n = 0; n < 2; ++n) acc[a][b][m][n] = (f32x4){0.f, 0.f, 0.f, 0.f};
        cur = nxt; cA = nA; cB = nB; ++ui;
        if (wr == 1) PG8_BAR;
    }
    PG8_WAIT_V(0);
    PG8_BAR;
#undef PG8_SA
#undef PG8_SB
#undef PG8_STAGE
#undef PG8_LDA
#undef PG8_LDB
#undef PG8_MMA
#undef PG8_WAIT_V
#undef PG8_WAIT_L
#undef PG8_BAR
#undef PG8_SCHED
}
}

#define XB_TMO      128
#define XB_XCNT(j)  (256  + 64 * (j))
#define XB_XSUB(j)  (1280 + 64 * (j))
#define XB_XGEN(j)  (2304 + 64 * (j))
#define XB_TOP      3328
#define XB_TOPGEN   3392
#define XCD_BAR_WORDS 3456
#define XB_SPIN_CAP (1u << 23)
__device__ __forceinline__ unsigned xb_ld(unsigned* p)              { return __hip_atomic_load(p, __ATOMIC_RELAXED, __HIP_MEMORY_SCOPE_AGENT); }
__device__ __forceinline__ unsigned xb_add(unsigned* p, unsigned v) { return __hip_atomic_fetch_add(p, v, __ATOMIC_RELAXED, __HIP_MEMORY_SCOPE_AGENT); }
__device__ __forceinline__ unsigned xb_xcc_id() { return (unsigned)__builtin_amdgcn_s_getreg((3 << 11) | 20) & 0xFu; }
#define XB_SPIN(cond, bar) do { unsigned _sp = 0; while (cond) { __builtin_amdgcn_s_sleep(1); \
    if ((++_sp & 255u) == 0u) { if (xb_ld(&(bar)[XB_TMO])) break; if (_sp > XB_SPIN_CAP) { atomicAdd(&(bar)[XB_TMO], 1u); break; } } } } while (0)
struct XcdBarrier { unsigned* bar; unsigned x; volatile LAS unsigned* st; };
__device__ __forceinline__ XcdBarrier xcd_barrier_post(unsigned* bar, volatile LAS unsigned* st) {
    XcdBarrier b; b.bar = bar; b.x = xb_xcc_id(); b.st = st;
    if (threadIdx.x == 0) (void)xb_add(&bar[XB_XCNT(b.x)], 1u);
    return b;
}
__device__ __forceinline__ void xcd_barrier_complete(unsigned* bar, unsigned x, unsigned& nloc, unsigned& nx) {
    const unsigned G = gridDim.x * gridDim.y * gridDim.z;
    unsigned sum, cnt, mine, sp = 0u;
    for (;;) {
        sum = 0u; cnt = 0u; mine = 0u;
#pragma unroll
        for (unsigned j = 0; j < 16; ++j) { const unsigned c = xb_ld(&bar[XB_XCNT(j)]); sum += c; cnt += (c > 0u) ? 1u : 0u; mine = (j == x) ? c : mine; }
        if (sum == G) break;
        __builtin_amdgcn_s_sleep(1);
        if ((++sp & 255u) == 0u) { if (xb_ld(&bar[XB_TMO])) break; if (sp > XB_SPIN_CAP) { atomicAdd(&bar[XB_TMO], 1u); break; } }
    }
    nloc = mine > 0u ? mine : 1u; nx = cnt > 0u ? cnt : 1u;
}
__device__ __forceinline__ void xcd_barrier(const XcdBarrier& b) {
    asm volatile("s_waitcnt vmcnt(0)" ::: "memory");
    __syncthreads();
    if (threadIdx.x == 0) {
        unsigned* bar = b.bar;
        __builtin_amdgcn_s_waitcnt(0);
        unsigned nloc = b.st[0], nx = b.st[1];
        if (nloc == 0u) { xcd_barrier_complete(bar, b.x, nloc, nx); b.st[0] = nloc; b.st[1] = nx; }
        const unsigned old = xb_add(&bar[XB_XSUB(b.x)], 1u);
        const unsigned gen = old / nloc;
        if (old + 1u == (gen + 1u) * nloc) {
            __builtin_amdgcn_fence(__ATOMIC_RELEASE, "agent");
            asm volatile("s_waitcnt vmcnt(0)" ::: "memory");
            const unsigned og = xb_add(&bar[XB_TOP], 1u);
            const unsigned tg = og / nx;
            if (og + 1u == (tg + 1u) * nx) xb_add(&bar[XB_TOPGEN], 1u);
            else XB_SPIN(xb_ld(&bar[XB_TOPGEN]) == tg, bar);
            __builtin_amdgcn_fence(__ATOMIC_ACQUIRE, "agent");
            xb_add(&bar[XB_XGEN(b.x)], 1u);
            asm volatile("s_waitcnt vmcnt(0)" ::: "memory");
        } else {
            XB_SPIN(xb_ld(&bar[XB_XGEN(b.x)]) == gen, bar);
            __builtin_amdgcn_fence(__ATOMIC_ACQUIRE, "agent");
            asm volatile("s_waitcnt vmcnt(0)" ::: "memory");
        }
    }
    __syncthreads();
}

struct TJ { int in, ldn, col0, K; unsigned long long dst; int row0, ncols, nvalid, il; };
constexpr int NTJ = 21;
__constant__ TJ tjobs[NTJ] = {
    {6, FF, 0, DM, W_GU1, 0, FF, FF, 1},      {7, FF, 0, DM, W_GU1, 128, FF, FF, 1},   {8, DM, 0, FF, W_D1, 0, DM, DM, 0},
    {23, FF, 0, DM, W_GU2, 0, FF, FF, 1},     {24, FF, 0, DM, W_GU2, 128, FF, FF, 1},  {25, DM, 0, FF, W_D2, 0, DM, DM, 0},
    {11, 5320, 640, DM, W_IN, 1024, 512, 512, 0},  {11, 5320, 1224, DM, W_IN, 1536, 512, 512, 0}, {11, 5320, 1736, DM, W_IN, 2048, 512, 512, 0},
    {11, 5320, 2248, DM, W_IN, 2560, 512, 512, 0}, {11, 5320, 2760, DM, W_IN, 3072, 512, 512, 0}, {11, 5320, 512, DM, W_IN, 3584, 128, 128, 0},
    {11, 5320, 1152, DM, W_IN, 3712, 64, 64, 0},   {11, 5320, 1216, DM, W_IN, 3776, 32, 8, 0},    {11, 5320, 0, DM, W_IN, 3808, 32, 0, 0},
    {11, 5320, 3272, DM, W_G, 0, 1024, 1024, 0},   {11, 5320, 4296, DM, W_G, 1024, 1024, 1024, 0},
    {18, DM, 0, 512, W_BRB, 0, DM, DM, 0},    {20, DM, 0, DM, W_OUT, 0, DM, DM, 0},    {28, DM, 0, DM, W_PG, 0, DM, DM, 0},      {29, DM, 0, PLE, W_PP, 0, DM, DM, 0},
};
__device__ __forceinline__ void transpose_item(const float* W, int ldn, int col0, int K, f16* WT, int row0, int nvalid, int il, LAS float* scr, int item, int ncols, int lane) {
    const int nblk = ncols / 32, kb = item / nblk, nb = item % nblk, k0 = 64 * kb, n0 = 32 * nb;
#pragma unroll
    for (int i = 0; i < 32; ++i) { const int kk = 2 * i + (lane >> 5); scr[kk * 33 + (lane & 31)] = W[(size_t)(k0 + kk) * ldn + col0 + n0 + (lane & 31)]; }
    LDS_WAIT();
    const int c = lane & 7;
#pragma unroll
    for (int j = 0; j < 4; ++j) { const int n = (lane >> 3) + 8 * j; const LAS float* s = scr + (8 * c) * 33 + n;
        f16x8 o;
#pragma unroll
        for (int e = 0; e < 8; ++e) o[e] = (n0 + n < nvalid) ? (f16)s[e * 33] : (f16)0.f;
        const int nn = n0 + n; const int drow = il ? (row0 + 256 * (nn >> 7) + (nn & 127)) : (row0 + nn);
        *(f16x8*)(WT + (size_t)drow * K + k0 + 8 * c) = o; }
    LDS_WAIT();
}

__device__ __forceinline__ void row_update(const float* hin, const f16* y, const float* gpost, float scale, float* hout, const float* gnext, f16* xn, int lane) {
    f32x4 h[4], yv[4]; float ss = 0.f;
#pragma unroll
    for (int j = 0; j < 4; ++j) { const int c = (lane + 64 * j) * 4; const f16x4 t = *(const f16x4*)(y + c); yv[j] = (f32x4){(float)t[0], (float)t[1], (float)t[2], (float)t[3]}; h[j] = *(const f32x4*)(hin + c);
        ss += (yv[j][0] * yv[j][0] + yv[j][1] * yv[j][1]) + (yv[j][2] * yv[j][2] + yv[j][3] * yv[j][3]); }
    const float rstd = scale * __builtin_amdgcn_rsqf(wave_sum(ss) * (1.f / DM) + EPS);
    float s2 = 0.f;
#pragma unroll
    for (int j = 0; j < 4; ++j) { const int c = (lane + 64 * j) * 4; const f32x4 g = *(const f32x4*)(gpost + c); h[j] = h[j] + yv[j] * rstd * g;
        s2 += (h[j][0] * h[j][0] + h[j][1] * h[j][1]) + (h[j][2] * h[j][2] + h[j][3] * h[j][3]); *(f32x4*)(hout + c) = h[j]; }
    if (gnext) {
        const float r2 = __builtin_amdgcn_rsqf(wave_sum(s2) * (1.f / DM) + EPS);
#pragma unroll
        for (int j = 0; j < 4; ++j) { const int c = (lane + 64 * j) * 4; const f32x4 g = *(const f32x4*)(gnext + c); const f32x4 o = h[j] * r2 * g;
            f16x4 w; w[0] = (f16)o[0]; w[1] = (f16)o[1]; w[2] = (f16)o[2]; w[3] = (f16)o[3]; *(f16x4*)(xn + c) = w; }
    }
}

__global__ void __launch_bounds__(NTHREADS, 2) mk_fwd(Args args_unused) {
    extern __shared__ __attribute__((aligned(16))) unsigned char lds_raw[];
    LAS unsigned char* lds = (LAS unsigned char*)lds_raw;
    const int tid = threadIdx.x, lane = tid & 63, wave = __builtin_amdgcn_readfirstlane(tid >> 6);
    const int G = gridDim.x; const int bx = blockIdx.x; const int vcu = (G % 8 == 0) ? (bx % 8) * (G / 8) + bx / 8 : bx;
    const int gw = vcu * NWAVES + wave, NGW = G * NWAVES;
    typedef const __attribute__((address_space(4))) Args* CArgsP;
    const CArgsP ap0 = (CArgsP)__builtin_amdgcn_kernarg_segment_ptr();
    unsigned* ctl = (unsigned*)(ap0->ws + WS_CTL);
    volatile LAS unsigned* MISC = (volatile LAS unsigned*)(lds + LDSCTL_OFF);
    for (int u = tid; u < 128; u += NTHREADS) MISC[u] = 0u;
    __syncthreads();
    const int lo = ap0->ph_lo, hi = ap0->ph_hi;
    XcdBarrier bar; bar.bar = ctl + CW_BAR; bar.x = 0; bar.st = nullptr;
    if (hi - lo > 1) bar = xcd_barrier_post(ctl + CW_BAR, MISC + 8);
#ifndef MK_PHASE_MASK
#define MK_PHASE_MASK 0xFFFFFFFFu
#endif
#define IN(k) ((((MK_PHASE_MASK) >> (k)) & 1u) && lo <= (k) && (k) < hi)
#ifndef MK_REP_MASK
#define MK_REP_MASK 0u
#endif
#define REPS(k) ((((MK_REP_MASK) >> (k)) & 1u) ? 2 : 1)
#define SEAM(k) do { if (IN(k) && IN((k) + 1)) xcd_barrier(bar); } while (0)

#define PH_BEGIN() CArgsP ap = ap0; asm volatile("" : "+s"(ap)); const __attribute__((address_space(4))) Args& args = *ap; unsigned char* const ws = args.ws; (void)ws; \
    f16* const XN = (f16*)(ws + WS_XN); f16* const Y = (f16*)(ws + WS_Y); f16* const ACT = (f16*)(ws + WS_ACT); \
    f16* const QLAT = (f16*)(ws + WS_QLAT); f16* const QIDX = (f16*)(ws + WS_QIDX); f16* const QH = (f16*)(ws + WS_QH); f16* const IH = (f16*)(ws + WS_IH); \
    f16* const GH = (f16*)(ws + WS_GH); float* const LOGF = (float*)(ws + WS_LOGF); float* const SMALL = (float*)(ws + WS_SMALL); \
    f16* const CKV = (f16*)(ws + WS_CKV); f16* const KIDX = (f16*)(ws + WS_KIDX); float* const WQ = (float*)(ws + WS_WQ); f16* const P16 = (f16*)(ws + WS_P16); \
    f16* const OH = (f16*)(ws + WS_OH); f16* const YB = (f16*)(ws + WS_YB); f16* const GT = (f16*)(ws + WS_G); f16* const MERGED = (f16*)(ws + WS_MERGED); f16* const GP = (f16*)(ws + WS_GP); \
    float* const LB = (float*)(ws + W_LB); float* const HOUT = args.out; \
    (void)XN; (void)Y; (void)ACT; (void)QLAT; (void)QIDX; (void)QH; (void)IH; (void)GH; (void)LOGF; (void)SMALL; (void)CKV; (void)KIDX; (void)WQ; (void)P16; (void)OH; (void)YB; (void)GT; (void)MERGED; (void)GP; (void)LB; (void)HOUT;

    if (IN(0)) for (int rep_ = 0; rep_ < REPS(0); ++rep_) { PH_BEGIN();
        {
            LAS float* wl = (LAS float*)(lds + 98304);
            const bool isq = vcu < 128; const int v2 = isq ? vcu : vcu - 128; const int h = v2 >> 4; const int idx = (v2 & 15) * 64 + lane;
            const float* src = (isq ? args.in[14] : args.in[15]) + (size_t)h * 128 * 64;
            if (vcu < 256) { for (int i = tid; i < 128 * 64 / 4; i += NTHREADS) ((LAS f32x4*)wl)[i] = ((const f32x4*)src)[i]; }
            LDS_WAIT(); __syncthreads();
            if (vcu < 256) {
                float a[64];
                if (isq) {
                    const float* win = args.in[11] + (size_t)idx * 5320 + h * 64;
#pragma unroll
                    for (int d = 0; d < 64; ++d) a[d] = win[d];
                    f16* dst = (f16*)(ws + W_IN);
                    for (int c = 16 * wave; c < 16 * wave + 16; ++c) { float s = 0.f;
#pragma unroll
                        for (int d = 0; d < 64; ++d) s += a[d] * wl[c * 64 + d];
                        dst[(size_t)(h * 128 + c) * DM + idx] = (f16)s; }
                } else {
                    const float* wb = args.in[17] + (size_t)(h * 64) * DM + idx;
#pragma unroll
                    for (int d = 0; d < 64; ++d) a[d] = wb[(size_t)d * DM];
                    f16* dst = (f16*)(ws + W_UVBR) + (size_t)idx * DM + h * 128;
                    for (int c8 = 2 * wave; c8 < 2 * wave + 2; ++c8) { f16x8 o;
#pragma unroll
                        for (int e = 0; e < 8; ++e) { float s = 0.f; const int c = c8 * 8 + e;
#pragma unroll
                            for (int d = 0; d < 64; ++d) s += a[d] * wl[c * 64 + d];
                            o[e] = (f16)s; }
                        *(f16x8*)(dst + c8 * 8) = o; }
                }
            }
        }
        if (vcu == 32 && tid < 512) { const float a0 = args.in[3][tid], a1 = args.in[3][512 + tid]; LB[tid] = 1.0f / (1.0f + __expf(a1 - a0)); }
        LAS float* scr = (LAS float*)(lds + wave * 8704);
        int tot = 0;
        for (int j = 0; j < NTJ; ++j) tot += (tjobs[j].K / 64) * (tjobs[j].ncols / 32);
        for (int it = gw; it < tot; it += NGW) {
            int r = it, j = 0;
            for (; j < NTJ; ++j) { const int n = (tjobs[j].K / 64) * (tjobs[j].ncols / 32); if (r < n) break; r -= n; }
            const TJ t = tjobs[j];
            transpose_item(args.in[t.in], t.ldn, t.col0, t.K, (f16*)(ws + t.dst), t.row0, t.nvalid, t.il, scr, r, t.ncols, lane);
        }
        for (int m0 = 2 * gw; m0 < M; m0 += 2 * NGW) {
            f32x4 v[2][4]; f32x4 pv[2]; float ss[2] = {0.f, 0.f};
#pragma unroll
            for (int rr = 0; rr < 2; ++rr) { const float* xr = args.in[0] + (size_t)(m0 + rr) * DM;
#pragma unroll
                for (int j = 0; j < 4; ++j) v[rr][j] = *(const f32x4*)(xr + (lane + 64 * j) * 4);
                pv[rr] = *(const f32x4*)(args.in[1] + (size_t)(m0 + rr) * PLE + lane * 4); }
#pragma unroll
            for (int rr = 0; rr < 2; ++rr)
#pragma unroll
                for (int j = 0; j < 4; ++j) ss[rr] += (v[rr][j][0] * v[rr][j][0] + v[rr][j][1] * v[rr][j][1]) + (v[rr][j][2] * v[rr][j][2] + v[rr][j][3] * v[rr][j][3]);
#pragma unroll
            for (int rr = 0; rr < 2; ++rr) { const int m = m0 + rr;
                const float rstd = __builtin_amdgcn_rsqf(wave_sum(ss[rr]) * (1.f / DM) + EPS);
#pragma unroll
                for (int j = 0; j < 4; ++j) { const int c = (lane + 64 * j) * 4; const f32x4 g = *(const f32x4*)(args.in[4] + c); const f32x4 o = v[rr][j] * rstd * g;
                    f16x4 w; w[0] = (f16)o[0]; w[1] = (f16)o[1]; w[2] = (f16)o[2]; w[3] = (f16)o[3]; *(f16x4*)(XN + (size_t)m * DM + c) = w; }
                f16x4 w; w[0] = (f16)pv[rr][0]; w[1] = (f16)pv[rr][1]; w[2] = (f16)pv[rr][2]; w[3] = (f16)pv[rr][3]; *(f16x4*)(P16 + (size_t)m * PLE + lane * 4) = w; }
        }
    }
    SEAM(0);
    if (IN(1)) for (int rep_ = 0; rep_ < REPS(1); ++rep_) { PH_BEGIN(); pg8::Gemm g{XN, (const f16*)(ws + W_GU1), M, 2 * FF, DM}; pg8::StaticOrder S; S.init(M, 2 * FF, G, bx);
        pg8::Epi<pg8::EP_SWIGLU> E{}; E.O = ACT; E.ldc = FF; pg8::gemm_phase(lds, g, S, E); }
    SEAM(1);
    if (IN(2)) for (int rep_ = 0; rep_ < REPS(2); ++rep_) { PH_BEGIN(); pg8::Gemm g{ACT, (const f16*)(ws + W_D1), M, DM, FF}; pg8::StaticOrder S; S.init(M, DM, G, bx);
        pg8::Epi<pg8::EP_F16> E{}; E.O = Y; E.ldc = DM; pg8::gemm_phase(lds, g, S, E); }
    SEAM(2);
    if (IN(3)) for (int rep_ = 0; rep_ < REPS(3); ++rep_) { PH_BEGIN(); for (int m = gw; m < M; m += NGW) row_update(args.in[0] + (size_t)m * DM, Y + (size_t)m * DM, args.in[5], 0.5f, HOUT + (size_t)m * DM, args.in[9], XN + (size_t)m * DM, lane); }
    SEAM(3);
    if (IN(4)) for (int rep_ = 0; rep_ < REPS(4); ++rep_) { PH_BEGIN(); pg8::Gemm g{XN, (const f16*)(ws + W_IN), M, NIN, DM}; pg8::StaticOrder S; S.init(M, NIN, G, bx);
        pg8::Epi<pg8::EP_INPROJ> E{}; E.qlat = QLAT; E.qidx = QIDX; E.qh = QH; E.ih = IH; E.gh = GH; E.logf = LOGF; E.small = SMALL; E.lb = LB; pg8::gemm_phase(lds, g, S, E); }
    SEAM(4);
    if (IN(5)) for (int rep_ = 0; rep_ < REPS(5); ++rep_) { PH_BEGIN();
        for (int m = gw; m < M; m += NGW) {
            const float* sr = SMALL + (size_t)m * 256;
            const f32x2 c2 = *(const f32x2*)(sr + 2 * lane); const float k1 = sr[128 + lane];
            const float rc = __builtin_amdgcn_rsqf(wave_sum(c2[0] * c2[0] + c2[1] * c2[1]) * (1.f / 128.f) + EPS);
            const float rk = __builtin_amdgcn_rsqf(wave_sum(k1 * k1) * (1.f / 64.f) + EPS);
            const f32x2 gc = *(const f32x2*)(args.in[12] + 2 * lane);
            f16x2 o; o[0] = (f16)(c2[0] * rc * gc[0]); o[1] = (f16)(c2[1] * rc * gc[1]); *(f16x2*)(CKV + (size_t)m * 128 + 2 * lane) = o;
            KIDX[(size_t)m * 64 + lane] = (f16)(k1 * rk * args.in[13][lane]);
            if (lane < 8) WQ[(size_t)m * 8 + lane] = sr[192 + lane] * 0.04419417382415922f;
        }
    }
    SEAM(5);
    if (IN(6)) for (int rep_ = 0; rep_ < REPS(6); ++rep_) { PH_BEGIN();
        constexpr int H_GF = 0, H_TOT = 16384, H_QS = 18432, H_Q1 = 26624, H_K0 = 30720, H_K1 = 34816, H_KST = 43008, H_V = 51200, H_D = 59392, H_GB = 59904, H_SS = 60928;
        float* const SSEG = (float*)(ws + WS_SMALL); float* const LSEG = (float*)(ws + WS_SMALL + 16 * MiB);
        const int t = tid >> 4, ch = tid & 15, fr = lane & 15, fg = lane >> 4, q_ = fr >> 2, p_ = fr & 3;
#define HG_CUMSUM() do { const int k_ = tid & 127, part_ = tid >> 7; LAS float* gf_ = (LAS float*)(lds + H_GF) + (8 * part_) * 128 + k_; float acc_ = 0.f; \
            _Pragma("unroll") for (int i_ = 0; i_ < 8; ++i_) { acc_ += gf_[i_ * 128]; gf_[i_ * 128] = acc_; } ((LAS float*)(lds + H_TOT))[part_ * 128 + k_] = acc_; } while (0)
#define HG_STORE(base, row, arr) do { u32x4 w_; w_[0] = pk_bf16(arr[0], arr[1]); w_[1] = pk_bf16(arr[2], arr[3]); w_[2] = pk_bf16(arr[4], arr[5]); w_[3] = pk_bf16(arr[6], arr[7]); *(LAS u32x4*)(lds + (base) + off_b((row), ch)) = w_; } while (0)
        for (int unit = vcu; unit < 256; unit += G) {
            const int bh = unit >> 3, seg = unit & 7, b = bh >> 2, h = bh & 3;
            const size_t rowbase = (size_t)b * SEQ * 512 + (size_t)seg * 512 * 512 + h * 128;
            f32x4 S[8];
#pragma unroll
            for (int m = 0; m < 8; ++m) S[m] = (f32x4){0.f, 0.f, 0.f, 0.f};
            if (tid < 128) ((LAS float*)(lds + H_GB))[tid] = 0.f;
            f32x4 ga, gb; f16x8 qv, vv;
            { const size_t ro = rowbase + (size_t)t * 512 + 8 * ch; ga = *(const f32x4*)(LOGF + ro); gb = *(const f32x4*)(LOGF + ro + 4); qv = *(const f16x8*)(QH + ro); vv = *(const f16x8*)(IH + ro); }
            for (int c = 0; c < 16; ++c) {
                *(LAS f32x4*)(lds + H_GF + t * 512 + ch * 32) = ga; *(LAS f32x4*)(lds + H_GF + t * 512 + ch * 32 + 16) = gb;
                { float vf[8];
#pragma unroll
                  for (int j = 0; j < 8; ++j) vf[j] = (float)vv[j];
                  HG_STORE(H_V, t, vf); }
                const f32x4 g0 = ga, g1 = gb; const f16x8 q8r = qv;
                if (c + 1 < 16) { const size_t ro = rowbase + (size_t)(32 * (c + 1) + t) * 512 + 8 * ch; ga = *(const f32x4*)(LOGF + ro); gb = *(const f32x4*)(LOGF + ro + 4); qv = *(const f16x8*)(QH + ro); vv = *(const f16x8*)(IH + ro); }
                LDS_WAIT(); __syncthreads();
                HG_CUMSUM();
                LDS_WAIT(); __syncthreads();
                {
                    const LAS float* gfr = (const LAS float*)(lds + H_GF); const LAS float* tot = (const LAS float*)(lds + H_TOT);
                    f32x4 G0 = *(const LAS f32x4*)(gfr + t * 128 + 8 * ch), G1 = *(const LAS f32x4*)(gfr + t * 128 + 8 * ch + 4);
                    const f32x4 t0a = *(const LAS f32x4*)(tot + 8 * ch), t0b = *(const LAS f32x4*)(tot + 8 * ch + 4);
                    const f32x4 t1a = *(const LAS f32x4*)(tot + 128 + 8 * ch), t1b = *(const LAS f32x4*)(tot + 128 + 8 * ch + 4);
                    const f32x4 t2a = *(const LAS f32x4*)(tot + 256 + 8 * ch), t2b = *(const LAS f32x4*)(tot + 256 + 8 * ch + 4);
                    const int part = t >> 3;
                    if (part >= 1) { G0 += t0a; G1 += t0b; } if (part >= 2) { G0 += t1a; G1 += t1b; } if (part >= 3) { G0 += t2a; G1 += t2b; }
                    const f32x4 G15a = *(const LAS f32x4*)(gfr + 15 * 128 + 8 * ch) + t0a, G15b = *(const LAS f32x4*)(gfr + 15 * 128 + 8 * ch + 4) + t0b;
                    const f32x4 GLa = *(const LAS f32x4*)(gfr + 31 * 128 + 8 * ch) + t0a + t1a + t2a, GLb = *(const LAS f32x4*)(gfr + 31 * 128 + 8 * ch + 4) + t0b + t1b + t2b;
                    float Gv[8], G15[8], GL[8], gr[8], qf[8];
#pragma unroll
                    for (int j = 0; j < 4; ++j) { Gv[j] = G0[j]; Gv[4 + j] = G1[j]; G15[j] = G15a[j]; G15[4 + j] = G15b[j]; GL[j] = GLa[j]; GL[4 + j] = GLb[j]; gr[j] = g0[j]; gr[4 + j] = g1[j]; }
#pragma unroll
                    for (int j = 0; j < 8; ++j) qf[j] = (float)q8r[j];
                    float qs[8], kst[8], x1[8], x2[8];
#pragma unroll
                    for (int j = 0; j < 8; ++j) { const float kk = 1.0f - __expf(gr[j]);
                        qs[j] = qf[j] * __expf(Gv[j]); kst[j] = kk * __expf(GL[j] - Gv[j]);
                        if (t < 16) { x1[j] = kk * __expf(fminf(-Gv[j], 80.f)); x2[j] = kk * __expf(G15[j] - Gv[j]); }
                        else { x1[j] = qf[j] * __expf(Gv[j] - G15[j]); x2[j] = kk * __expf(fminf(G15[j] - Gv[j], 80.f)); } }
                    HG_STORE(H_QS, t, qs); HG_STORE(H_KST, t, kst); HG_STORE(H_K1, t, x2);
                    if (t < 16) HG_STORE(H_K0, t, x1); else HG_STORE(H_Q1, t - 16, x1);
                    if (t == 0) { f32x4 d0, d1; LAS float* gbp = (LAS float*)(lds + H_GB) + 8 * ch;
#pragma unroll
                        for (int j = 0; j < 4; ++j) { d0[j] = __expf(GL[j]); d1[j] = __expf(GL[4 + j]); gbp[j] += GL[j]; gbp[4 + j] += GL[4 + j]; }
                        *(LAS f32x4*)(lds + H_D + 32 * ch) = d0; *(LAS f32x4*)(lds + H_D + 32 * ch + 16) = d1; }
                }
                LDS_WAIT(); __syncthreads();
                {
                    f32x4 at00 = {0.f, 0.f, 0.f, 0.f}, at10 = at00, at11 = at00;
#pragma unroll
                    for (int ks = 0; ks < 4; ++ks) {
                        const bf16x8 k0f = *(const LAS bf16x8*)(lds + H_K0 + off_b(fr, 4 * ks + fg)), q0f = *(const LAS bf16x8*)(lds + H_QS + off_b(fr, 4 * ks + fg));
                        const bf16x8 k1a = *(const LAS bf16x8*)(lds + H_K1 + off_b(fr, 4 * ks + fg)), k1b = *(const LAS bf16x8*)(lds + H_K1 + off_b(16 + fr, 4 * ks + fg));
                        const bf16x8 q1f = *(const LAS bf16x8*)(lds + H_Q1 + off_b(fr, 4 * ks + fg));
                        at00 = __builtin_amdgcn_mfma_f32_16x16x32_bf16(k0f, q0f, at00, 0, 0, 0);
                        at10 = __builtin_amdgcn_mfma_f32_16x16x32_bf16(k1a, q1f, at10, 0, 0, 0);
                        at11 = __builtin_amdgcn_mfma_f32_16x16x32_bf16(k1b, q1f, at11, 0, 0, 0);
                    }
#pragma unroll
                    for (int r = 0; r < 4; ++r) { if (4 * fg + r > fr) { at00[r] = 0.f; at11[r] = 0.f; } }
                    const unsigned vco = (unsigned)(2 * wave + (p_ >> 1)), vbo = 8u * (unsigned)(p_ & 1);
                    const bf16x8 vt = cat44(lds_tr16(lds + H_V + off_b(4 * fg + q_, vco) + vbo), lds_tr16(lds + H_V + off_b(16 + 4 * fg + q_, vco) + vbo));
                    const f32x4 z = {0.f, 0.f, 0.f, 0.f};
                    f32x4 oi[2];
                    oi[0] = __builtin_amdgcn_mfma_f32_16x16x32_bf16(vt, pack_bf8(at00, z), z, 0, 0, 0);
                    oi[1] = __builtin_amdgcn_mfma_f32_16x16x32_bf16(vt, pack_bf8(at10, at11), z, 0, 0, 0);
#pragma unroll
                    for (int ks = 0; ks < 4; ++ks) {
                        const bf16x8 sop = pack_bf8(S[2 * ks], S[2 * ks + 1]);
#pragma unroll
                        for (int blk = 0; blk < 2; ++blk) {
                            const s16x4 qa = *(const LAS s16x4*)(lds + H_QS + off_b(16 * blk + fr, 4 * ks + (fg >> 1)) + 8 * (fg & 1));
                            const s16x4 qb = *(const LAS s16x4*)(lds + H_QS + off_b(16 * blk + fr, 4 * ks + 2 + (fg >> 1)) + 8 * (fg & 1));
                            oi[blk] = __builtin_amdgcn_mfma_f32_16x16x32_bf16(sop, cat44(qa, qb), oi[blk], 0, 0, 0);
                        }
                    }
                    const bf16x8 vb = cat44(lds_tr16(lds + H_V + off_b(8 * fg + q_, vco) + vbo), lds_tr16(lds + H_V + off_b(8 * fg + 4 + q_, vco) + vbo));
#pragma unroll
                    for (int m = 0; m < 8; ++m) {
                        const bf16x8 ka = cat44(lds_tr16(lds + H_KST + off_b(8 * fg + q_, 2 * m + (p_ >> 1)) + 8 * (p_ & 1)), lds_tr16(lds + H_KST + off_b(8 * fg + 4 + q_, 2 * m + (p_ >> 1)) + 8 * (p_ & 1)));
                        const f32x4 dv = *(const LAS f32x4*)(lds + H_D + (16 * m + 4 * fg) * 4);
                        S[m] = __builtin_amdgcn_mfma_f32_16x16x32_bf16(ka, vb, S[m] * dv, 0, 0, 0);
                    }
#pragma unroll
                    for (int blk = 0; blk < 2; ++blk) {
                        f16x4 w; w[0] = (f16)oi[blk][0]; w[1] = (f16)oi[blk][1]; w[2] = (f16)oi[blk][2]; w[3] = (f16)oi[blk][3];
                        *(f16x4*)(OH + rowbase + (size_t)(32 * c + 16 * blk + fr) * 512 + 16 * wave + 4 * fg) = w;
                    }
                }
                LDS_WAIT(); __syncthreads();
            }
            { float* sp = SSEG + ((size_t)unit * 128) * 128 + 16 * wave + fr;
#pragma unroll
              for (int m = 0; m < 8; ++m)
#pragma unroll
                  for (int r = 0; r < 4; ++r) sp[(size_t)(16 * m + 4 * fg + r) * 128] = S[m][r];
              if (tid < 128) LSEG[unit * 128 + tid] = ((LAS float*)(lds + H_GB))[tid]; }
            __syncthreads();
        }
        if (hi - lo > 1) xcd_barrier(bar);
        for (int unit = vcu; unit < 256; unit += G) {
            const int bh = unit >> 3, seg = unit & 7, b = bh >> 2, h = bh & 3;
            const size_t rowbase = (size_t)b * SEQ * 512 + (size_t)seg * 512 * 512 + h * 128;
            f32x4 S[8];
#pragma unroll
            for (int m = 0; m < 8; ++m) S[m] = (f32x4){0.f, 0.f, 0.f, 0.f};
            for (int j = 0; j < seg; ++j) {
                const float* sp = SSEG + ((size_t)(bh * 8 + j) * 128) * 128 + 16 * wave + fr; const float* lp = LSEG + (bh * 8 + j) * 128;
#pragma unroll
                for (int m = 0; m < 8; ++m) { const f32x4 lv = *(const f32x4*)(lp + 16 * m + 4 * fg);
#pragma unroll
                    for (int r = 0; r < 4; ++r) S[m][r] = S[m][r] * __expf(lv[r]) + sp[(size_t)(16 * m + 4 * fg + r) * 128]; }
            }
            bf16x8 sop[4];
#pragma unroll
            for (int ks = 0; ks < 4; ++ks) sop[ks] = pack_bf8(S[2 * ks], S[2 * ks + 1]);
            if (tid < 256) ((LAS float*)(lds + H_GB))[tid] = 0.f;
            f32x4 ga, gb; f16x8 qv;
            { const size_t ro = rowbase + (size_t)t * 512 + 8 * ch; ga = *(const f32x4*)(LOGF + ro); gb = *(const f32x4*)(LOGF + ro + 4); qv = *(const f16x8*)(QH + ro); }
            const f32x4 gn4 = *(const f32x4*)(args.in[16] + 16 * wave + 4 * fg);
            for (int c = 0; c < 16; ++c) {
                *(LAS f32x4*)(lds + H_GF + t * 512 + ch * 32) = ga; *(LAS f32x4*)(lds + H_GF + t * 512 + ch * 32 + 16) = gb;
                const f16x8 q8r = qv;
                if (c + 1 < 16) { const size_t ro = rowbase + (size_t)(32 * (c + 1) + t) * 512 + 8 * ch; ga = *(const f32x4*)(LOGF + ro); gb = *(const f32x4*)(LOGF + ro + 4); qv = *(const f16x8*)(QH + ro); }
                LDS_WAIT(); __syncthreads();
                HG_CUMSUM();
                LDS_WAIT(); __syncthreads();
                {
                    const LAS float* gfr = (const LAS float*)(lds + H_GF); const LAS float* tot = (const LAS float*)(lds + H_TOT);
                    const LAS float* gbc = (const LAS float*)(lds + H_GB) + (c & 1) * 128; LAS float* gbn = (LAS float*)(lds + H_GB) + ((c + 1) & 1) * 128;
                    f32x4 G0 = *(const LAS f32x4*)(gfr + t * 128 + 8 * ch), G1 = *(const LAS f32x4*)(gfr + t * 128 + 8 * ch + 4);
                    const f32x4 t0a = *(const LAS f32x4*)(tot + 8 * ch), t0b = *(const LAS f32x4*)(tot + 8 * ch + 4);
                    const f32x4 t1a = *(const LAS f32x4*)(tot + 128 + 8 * ch), t1b = *(const LAS f32x4*)(tot + 128 + 8 * ch + 4);
                    const f32x4 t2a = *(const LAS f32x4*)(tot + 256 + 8 * ch), t2b = *(const LAS f32x4*)(tot + 256 + 8 * ch + 4);
                    const int part = t >> 3;
                    if (part >= 1) { G0 += t0a; G1 += t0b; } if (part >= 2) { G0 += t1a; G1 += t1b; } if (part >= 3) { G0 += t2a; G1 += t2b; }
                    const f32x4 ba = *(const LAS f32x4*)(gbc + 8 * ch), bb = *(const LAS f32x4*)(gbc + 8 * ch + 4);
                    float qs[8];
#pragma unroll
                    for (int j = 0; j < 4; ++j) { qs[j] = (float)q8r[j] * __expf(G0[j] + ba[j]); qs[4 + j] = (float)q8r[4 + j] * __expf(G1[j] + bb[j]); }
                    HG_STORE(H_QS, t, qs);
                    if (t == 31) { *(LAS f32x4*)(gbn + 8 * ch) = G0 + ba; *(LAS f32x4*)(gbn + 8 * ch + 4) = G1 + bb; }
                }
                LDS_WAIT(); __syncthreads();
                f32x4 of[2];
#pragma unroll
                for (int blk = 0; blk < 2; ++blk) {
                    const f16x4 ol = *(const f16x4*)(OH + rowbase + (size_t)(32 * c + 16 * blk + fr) * 512 + 16 * wave + 4 * fg);
                    of[blk] = (f32x4){(float)ol[0], (float)ol[1], (float)ol[2], (float)ol[3]};
                }
                if (seg > 0) {
#pragma unroll
                    for (int ks = 0; ks < 4; ++ks)
#pragma unroll
                        for (int blk = 0; blk < 2; ++blk) {
                            const s16x4 qa = *(const LAS s16x4*)(lds + H_QS + off_b(16 * blk + fr, 4 * ks + (fg >> 1)) + 8 * (fg & 1));
                            const s16x4 qb = *(const LAS s16x4*)(lds + H_QS + off_b(16 * blk + fr, 4 * ks + 2 + (fg >> 1)) + 8 * (fg & 1));
                            of[blk] = __builtin_amdgcn_mfma_f32_16x16x32_bf16(sop[ks], cat44(qa, qb), of[blk], 0, 0, 0);
                        }
                }
#pragma unroll
                for (int blk = 0; blk < 2; ++blk) {
                    float ss = (of[blk][0] * of[blk][0] + of[blk][1] * of[blk][1]) + (of[blk][2] * of[blk][2] + of[blk][3] * of[blk][3]);
                    ss += __shfl_xor(ss, 16); ss += __shfl_xor(ss, 32);
                    if (fg == 0) ((LAS float*)(lds + H_SS))[wave * 32 + 16 * blk + fr] = ss;
                }
                LDS_WAIT(); __syncthreads();
#pragma unroll
                for (int blk = 0; blk < 2; ++blk) {
                    float tot2 = 0.f;
#pragma unroll
                    for (int w8 = 0; w8 < 8; ++w8) tot2 += ((const LAS float*)(lds + H_SS))[w8 * 32 + 16 * blk + fr];
                    const float rstd = __builtin_amdgcn_rsqf(tot2 * (1.f / 128.f) + EPS);
                    const size_t oo = rowbase + (size_t)(32 * c + 16 * blk + fr) * 512 + 16 * wave + 4 * fg;
                    const f16x4 gh4 = *(const f16x4*)(GH + oo);
                    f16x4 w;
#pragma unroll
                    for (int r = 0; r < 4; ++r) w[r] = (f16)(of[blk][r] * rstd * gn4[r] * (float)gh4[r]);
                    *(f16x4*)(YB + oo) = w;
                }
            }
            __syncthreads();
        }
#undef HG_CUMSUM
#undef HG_STORE
    }
    SEAM(6);
    if (IN(7)) for (int rep_ = 0; rep_ < REPS(7); ++rep_) { PH_BEGIN();
        LAS float* relb = (LAS float*)(lds + TAB_OFF); LAS int* bkt = (LAS int*)(lds + TAB_OFF + 2048);
        relb[tid] = ((tid & 15) < 8) ? args.in[2][(tid >> 4) * 8 + (tid & 15)] : 0.f;
        if (tid < 128) { int bk = tid; if (tid >= 16) { const float vv = __logf((float)tid / 16.f) / 2.0794415416798357f * 16.f; bk = 16 + (int)vv; bk = bk > 31 ? 31 : bk; } bkt[tid] = bk; }
        __syncthreads();
        LAS unsigned char* const cbuf = lds + wave * 16384;
        LAS unsigned* const lst = (LAS unsigned*)(lds + WSM_OFF + wave * WSM_BYTES);
        unsigned* const SCR = (unsigned*)(ws + WS_QH) + (size_t)bx * (16 * 4096);
        constexpr unsigned KMIN = 0x007FFFFFu;
        for (int un = bx; un < 2048; un += G) {
            const int b = un & 7, idx = un >> 3, jj_ = idx & 31, kk_ = idx >> 5; const int qt = (kk_ & 1) ? 32 * kk_ + 31 - jj_ : 32 * kk_ + jj_;
            const int q0 = b * SEQ + 16 * qt;
            {
                const int fr = lane & 15, fq = lane >> 4;
                f16x8 Qf[8][2];
                const f16* qp = QIDX + (size_t)(q0 + fr) * 512 + 8 * fq;
#pragma unroll
                for (int h = 0; h < 8; ++h) { Qf[h][0] = *(const f16x8*)(qp + h * 64); Qf[h][1] = *(const f16x8*)(qp + h * 64 + 32); }
                const f32x4 w0 = *(const f32x4*)(WQ + (size_t)(q0 + fr) * 8), w1 = *(const f32x4*)(WQ + (size_t)(q0 + fr) * 8 + 4);
                const int nkt = qt + 1;
                for (int kt = wave; kt < nkt; kt += 8) {
                    const f16* kp = KIDX + ((size_t)b * SEQ + 16 * kt + fr) * 64 + 8 * fq;
                    const f16x8 A0 = *(const f16x8*)kp, A1 = *(const f16x8*)(kp + 32);
                    f32x4 sc4 = {0.f, 0.f, 0.f, 0.f};
#pragma unroll
                    for (int h = 0; h < 8; ++h) {
                        f32x4 d = __builtin_amdgcn_mfma_f32_16x16x32_f16(A0, Qf[h][0], (f32x4){0.f, 0.f, 0.f, 0.f}, 0, 0, 0);
                        d = __builtin_amdgcn_mfma_f32_16x16x32_f16(A1, Qf[h][1], d, 0, 0, 0);
                        const float wh = h < 4 ? w0[h] : w1[h - 4];
#pragma unroll
                        for (int r = 0; r < 4; ++r) sc4[r] += wh * fmaxf(d[r], 0.f);
                    }
                    u32x4 o;
#pragma unroll
                    for (int r = 0; r < 4; ++r) { const unsigned x = __float_as_uint(sc4[r]); o[r] = (x & 0x80000000u) ? ~x : (x | 0x80000000u); }
                    *(u32x4*)(SCR + fr * 4096 + 16 * kt + 4 * fq) = o;
                }
            }
            VM_WAIT(); __syncthreads();
            for (int qi = 2 * wave; qi < 2 * wave + 2; ++qi) {
                const int q = q0 + qi, t = 16 * qt + qi;
                const unsigned* sp = SCR + qi * 4096;
                unsigned uk[64];
#pragma unroll
                for (int j = 0; j < 16; ++j) {
                    u32x4 v = {KMIN, KMIN, KMIN, KMIN};
                    if (256 * j <= t) v = *(const u32x4*)(sp + 256 * j + 4 * lane);
#pragma unroll
                    for (int e = 0; e < 4; ++e) uk[4 * j + e] = (256 * j + 4 * lane + e <= t) ? v[e] : KMIN;
                }
                unsigned Tk = KMIN; int r = 0;
                if (t + 1 > 256) {
                    unsigned lo_ = 0x00800000u, hi_ = 0xFFFFFFFFu;
                    while (lo_ < hi_) {
                        const unsigned mid = lo_ + ((hi_ - lo_) >> 1) + 1u; int c = 0;
#pragma unroll
                        for (int i = 0; i < 64; ++i) { c += __popcll(__ballot(uk[i] >= mid)); if ((i & 3) == 3) asm volatile("" : "+s"(c)); }
                        if (c == 256) { lo_ = mid - 1u; hi_ = mid - 1u; break; }
                        if (c > 256) lo_ = mid; else hi_ = mid - 1u;
                    }
                    Tk = lo_; int cg = 0;
#pragma unroll
                    for (int i = 0; i < 64; ++i) { cg += __popcll(__ballot(uk[i] > Tk)); if ((i & 3) == 3) asm volatile("" : "+s"(cg)); }
                    r = 256 - cg;
                }
                int nb = 0, eb = 0;
#pragma unroll
                for (int j = 0; j < 16; ++j) {
                    if (256 * j <= t) {
                        bool gt[4], eq[4], sel[4]; int leq = 0, teq = 0;
#pragma unroll
                        for (int e = 0; e < 4; ++e) { gt[e] = uk[4 * j + e] > Tk; eq[e] = uk[4 * j + e] == Tk; const unsigned long long me = __ballot(eq[e]);
                            leq += (int)__builtin_amdgcn_mbcnt_hi((unsigned)(me >> 32), __builtin_amdgcn_mbcnt_lo((unsigned)me, 0u)); teq += __popcll(me); }
                        int run = eb + leq, lsel = 0, tsel = 0;
#pragma unroll
                        for (int e = 0; e < 4; ++e) { sel[e] = gt[e] || (eq[e] && run < r); run += eq[e] ? 1 : 0; const unsigned long long ms = __ballot(sel[e]);
                            lsel += (int)__builtin_amdgcn_mbcnt_hi((unsigned)(ms >> 32), __builtin_amdgcn_mbcnt_lo((unsigned)ms, 0u)); tsel += __popcll(ms); }
                        int pos = nb + lsel;
#pragma unroll
                        for (int e = 0; e < 4; ++e) { if (sel[e]) { const int sk = 256 * j + 4 * lane + e; int dd = t - sk; dd = dd > 127 ? 127 : dd; lst[pos] = (unsigned)sk | ((unsigned)bkt[dd] << 16); ++pos; } }
                        nb += tsel; eb += teq;
                        asm volatile("" : "+s"(nb), "+s"(eb));
                    }
                }
                LDS_WAIT();
                const int nsel = nb;
                const int nch = (nsel + 31) >> 5;
                if (lane < nch * 32 - nsel) lst[nsel + lane] = 0u;
                LDS_WAIT();
                const int fr = lane & 15, fg = lane >> 4, q_ = fr >> 2, p_ = fr & 3;
                f16x8 qB[4];
#pragma unroll
                for (int ks = 0; ks < 4; ++ks) { qB[ks] = (f16x8){0, 0, 0, 0, 0, 0, 0, 0}; if (fr < 8) qB[ks] = *(const f16x8*)(QLAT + (size_t)q * 1024 + fr * 128 + 32 * ks + 8 * fg); }
                const f16* cbase = CKV + (size_t)b * SEQ * 128;
#define AT_GATHER(ci) do { LAS unsigned char* dst_ = cbuf + ((ci) & 1) * 8192; _Pragma("unroll") for (int i_ = 0; i_ < 8; ++i_) { \
                    const unsigned en_ = lst[(ci) * 32 + 4 * i_ + fg]; const unsigned sw_ = (unsigned)((fg << 2) | (i_ & 3)); \
                    __builtin_amdgcn_global_load_lds((const unsigned*)(cbase + (size_t)(en_ & 0xFFFFu) * 128 + 8 * (fr ^ sw_)), (LAS unsigned*)(dst_ + i_ * 1024), 16, 0, 0); } } while (0)
                AT_GATHER(0);
                f32x4 O[8];
#pragma unroll
                for (int c = 0; c < 8; ++c) O[c] = (f32x4){0.f, 0.f, 0.f, 0.f};
                float m_run = -__builtin_inff(), l_run = 0.f;
                for (int ci = 0; ci < nch; ++ci) {
                    LDS_WAIT();
                    if (ci + 1 < nch) { AT_GATHER(ci + 1); asm volatile("s_waitcnt vmcnt(8)" ::: "memory"); } else { asm volatile("s_waitcnt vmcnt(0)" ::: "memory"); }
                    const LAS unsigned char* buf = cbuf + (ci & 1) * 8192;
                    f32x4 d0 = {0.f, 0.f, 0.f, 0.f}, d1 = d0;
#pragma unroll
                    for (int ks = 0; ks < 4; ++ks) {
                        const f16x8 a0 = *(const LAS f16x8*)(buf + off_b(8 * q_ + p_, 4 * ks + fg)), a1 = *(const LAS f16x8*)(buf + off_b(8 * q_ + 4 + p_, 4 * ks + fg));
                        d0 = __builtin_amdgcn_mfma_f32_16x16x32_f16(a0, qB[ks], d0, 0, 0, 0);
                        d1 = __builtin_amdgcn_mfma_f32_16x16x32_f16(a1, qB[ks], d1, 0, 0, 0);
                    }
                    const u32x4 e0 = *(const LAS u32x4*)(lst + ci * 32 + 8 * fg), e1 = *(const LAS u32x4*)(lst + ci * 32 + 8 * fg + 4);
                    float lg[8];
#pragma unroll
                    for (int r = 0; r < 4; ++r) {
                        lg[r] = (ci * 32 + 8 * fg + r < nsel) ? d0[r] * 0.125f + relb[(e0[r] >> 16) * 16 + fr] : -__builtin_inff();
                        lg[4 + r] = (ci * 32 + 8 * fg + 4 + r < nsel) ? d1[r] * 0.125f + relb[(e1[r] >> 16) * 16 + fr] : -__builtin_inff();
                    }
                    float mx = fmaxf(fmaxf(fmaxf(lg[0], lg[1]), fmaxf(lg[2], lg[3])), fmaxf(fmaxf(lg[4], lg[5]), fmaxf(lg[6], lg[7])));
                    mx = fmaxf(mx, __shfl_xor(mx, 16)); mx = fmaxf(mx, __shfl_xor(mx, 32));
                    const float m_new = fmaxf(m_run, mx);
                    const float alpha = __expf(m_run - m_new);
                    m_run = m_new;
                    float pr[8], ps = 0.f;
#pragma unroll
                    for (int r = 0; r < 8; ++r) { pr[r] = __expf(lg[r] - m_new); ps += pr[r]; }
                    l_run = l_run * alpha + ps;
                    f16x8 pa;
#pragma unroll
                    for (int r = 0; r < 8; ++r) pa[r] = (f16)pr[r];
                    float al[4];
#pragma unroll
                    for (int r = 0; r < 4; ++r) al[r] = __shfl(alpha, 4 * fg + r);
#pragma unroll
                    for (int c = 0; c < 8; ++c) {
#pragma unroll
                        for (int r = 0; r < 4; ++r) O[c][r] *= al[r];
                        const s16x4 t0 = lds_tr16(buf + off_b(8 * fg + q_, 2 * c + (p_ >> 1)) + 8 * (p_ & 1)), t1 = lds_tr16(buf + off_b(8 * fg + 4 + q_, 2 * c + (p_ >> 1)) + 8 * (p_ & 1));
                        O[c] = __builtin_amdgcn_mfma_f32_16x16x32_f16(pa, __builtin_bit_cast(f16x8, cat44(t0, t1)), O[c], 0, 0, 0);
                    }
                }
#undef AT_GATHER
                float lt = l_run; lt += __shfl_xor(lt, 16); lt += __shfl_xor(lt, 32);
                const float inv = 1.0f / lt;
                float iv[4];
#pragma unroll
                for (int r = 0; r < 4; ++r) iv[r] = __shfl(inv, 4 * fg + r);
                if (fg < 2) {
#pragma unroll
                    for (int c = 0; c < 8; ++c)
#pragma unroll
                        for (int r = 0; r < 4; ++r) QLAT[(size_t)q * 1024 + (4 * fg + r) * 128 + 16 * c + fr] = (f16)(O[c][r] * iv[r]);
                }
                LDS_WAIT();
            }
            __syncthreads();
        }
    }
    SEAM(7);
    if (IN(8)) for (int rep_ = 0; rep_ < REPS(8); ++rep_) { PH_BEGIN(); pg8::Gemm g{XN, (const f16*)(ws + W_G), M, NGATE, DM}; pg8::StaticOrder S; S.init(M, NGATE, G, bx);
        pg8::Epi<pg8::EP_GATES> E{}; E.O = GT; E.ldc = NGATE; E.bias = args.in[19]; pg8::gemm_phase(lds, g, S, E); }
    SEAM(8);
    if (IN(9)) for (int rep_ = 0; rep_ < REPS(9); ++rep_) { PH_BEGIN(); pg8::Gemm g{QLAT, (const f16*)(ws + W_UVBR), M, DM, DM}; pg8::StaticOrder S; S.init(M, DM, G, bx);
        pg8::Epi<pg8::EP_BRA> E{}; E.O = MERGED; E.ldc = DM; E.Gt = GT; pg8::gemm_phase(lds, g, S, E); }
    if (IN(10)) for (int rep_ = 0; rep_ < REPS(10); ++rep_) { PH_BEGIN(); pg8::Gemm g{YB, (const f16*)(ws + W_BRB), M, DM, 512}; pg8::StaticOrder S; S.init(M, DM, G, bx);
        pg8::Epi<pg8::EP_BRB> E{}; E.O = MERGED; E.ldc = DM; E.Gt = GT; pg8::gemm_phase(lds, g, S, E); }
    SEAM(10);
    if (IN(11)) for (int rep_ = 0; rep_ < REPS(11); ++rep_) { PH_BEGIN(); pg8::Gemm g{MERGED, (const f16*)(ws + W_OUT), M, DM, DM}; pg8::StaticOrder S; S.init(M, DM, G, bx);
        pg8::Epi<pg8::EP_F16> E{}; E.O = Y; E.ldc = DM; pg8::gemm_phase(lds, g, S, E); }
    SEAM(11);
    if (IN(12)) for (int rep_ = 0; rep_ < REPS(12); ++rep_) { PH_BEGIN(); for (int m = gw; m < M; m += NGW) row_update(HOUT + (size_t)m * DM, Y + (size_t)m * DM, args.in[10], 1.0f, HOUT + (size_t)m * DM, args.in[21], XN + (size_t)m * DM, lane); }
    SEAM(12);
    if (IN(13)) for (int rep_ = 0; rep_ < REPS(13); ++rep_) { PH_BEGIN(); pg8::Gemm g{XN, (const f16*)(ws + W_GU2), M, 2 * FF, DM}; pg8::StaticOrder S; S.init(M, 2 * FF, G, bx);
        pg8::Epi<pg8::EP_SWIGLU> E{}; E.O = ACT; E.ldc = FF; pg8::gemm_phase(lds, g, S, E); }
    SEAM(13);
    if (IN(14)) for (int rep_ = 0; rep_ < REPS(14); ++rep_) { PH_BEGIN(); pg8::Gemm g{ACT, (const f16*)(ws + W_D2), M, DM, FF}; pg8::StaticOrder S; S.init(M, DM, G, bx);
        pg8::Epi<pg8::EP_F16> E{}; E.O = Y; E.ldc = DM; pg8::gemm_phase(lds, g, S, E); }
    SEAM(14);
    if (IN(15)) for (int rep_ = 0; rep_ < REPS(15); ++rep_) { PH_BEGIN(); for (int m = gw; m < M; m += NGW) row_update(HOUT + (size_t)m * DM, Y + (size_t)m * DM, args.in[22], 0.5f, HOUT + (size_t)m * DM, args.in[26], XN + (size_t)m * DM, lane); }
    SEAM(15);
    if (IN(16)) for (int rep_ = 0; rep_ < REPS(16); ++rep_) { PH_BEGIN(); pg8::Gemm g{XN, (const f16*)(ws + W_PG), M, DM, DM}; pg8::StaticOrder S; S.init(M, DM, G, bx);
        pg8::Epi<pg8::EP_PLE1> E{}; E.O = GP; E.ldc = DM; pg8::gemm_phase(lds, g, S, E); }
    if (IN(17)) for (int rep_ = 0; rep_ < REPS(17); ++rep_) { PH_BEGIN(); pg8::Gemm g{P16, (const f16*)(ws + W_PP), M, DM, PLE}; pg8::StaticOrder S; S.init(M, DM, G, bx);
        pg8::Epi<pg8::EP_PLE2> E{}; E.O = Y; E.ldc = DM; E.Gt = GP; pg8::gemm_phase(lds, g, S, E); }
    SEAM(17);
    if (IN(18)) for (int rep_ = 0; rep_ < REPS(18); ++rep_) { PH_BEGIN(); for (int m = gw; m < M; m += NGW) row_update(HOUT + (size_t)m * DM, Y + (size_t)m * DM, args.in[27], 1.0f, HOUT + (size_t)m * DM, nullptr, nullptr, lane); }
#undef IN
#undef SEAM
#undef PH_BEGIN
}

extern "C" void kernel_launch(void* const* d_in, const int* in_sizes, int n_in, void* d_out, int out_size, void* d_ws, size_t ws_size, hipStream_t stream) {
    static int grid = 0;
    if (grid == 0) {
        if (n_in != 30 || in_sizes[0] != M * DM || out_size != M * DM || ws_size < WS_END) {
            fprintf(stderr, "kernel_launch: unexpected shapes/workspace (n_in %d, in0 %d, out %d, ws %zu)\n", n_in, n_in > 0 ? in_sizes[0] : -1, out_size, ws_size); grid = -1; return; }
        int dev = 0, cus = 0;
        if (hipGetDevice(&dev) != hipSuccess || hipDeviceGetAttribute(&cus, hipDeviceAttributeMultiprocessorCount, dev) != hipSuccess) { grid = -1; return; }
        if (hipFuncSetAttribute((const void*)mk_fwd, hipFuncAttributeMaxDynamicSharedMemorySize, LDS_BYTES) != hipSuccess) { fprintf(stderr, "kernel_launch: hipFuncSetAttribute failed\n"); grid = -1; return; }
        (void)hipGetLastError();
        grid = cus;
    }
    if (grid < 0) return;
    (void)hipMemsetAsync((char*)d_ws + WS_CTL, 0, CTL_ZERO_BYTES, stream);
    Args a{};
    for (int i = 0; i < 30; ++i) a.in[i] = (const float*)d_in[i];
    a.out = (float*)d_out; a.ws = (unsigned char*)d_ws;
#if MK_PER_PHASE_LAUNCH
    for (int ph = 0; ph < NPHASE; ++ph) { a.ph_lo = ph; a.ph_hi = ph + 1; hipLaunchKernelGGL(mk_fwd, dim3(grid), dim3(NTHREADS), LDS_BYTES, stream, a); }
#else
    a.ph_lo = 0; a.ph_hi = NPHASE; hipLaunchKernelGGL(mk_fwd, dim3(grid), dim3(NTHREADS), LDS_BYTES, stream, a);
#endif
}
```

```cpp
#include <hip/hip_runtime.h>
#include <cstdio>
#include <cstdint>

#ifndef MK_PER_PHASE_LAUNCH
#define MK_PER_PHASE_LAUNCH 0
#endif

#define LAS __attribute__((address_space(3)))
#define GAS __attribute__((address_space(1)))
typedef _Float16 f16;
typedef _Float16 f16x2 __attribute__((ext_vector_type(2)));
typedef _Float16 f16x4 __attribute__((ext_vector_type(4)));
typedef _Float16 f16x8 __attribute__((ext_vector_type(8)));
typedef float f32x2 __attribute__((ext_vector_type(2)));
typedef float f32x4 __attribute__((ext_vector_type(4)));
typedef unsigned u32x4 __attribute__((ext_vector_type(4)));

constexpr int BATCH = 8, SEQ = 4096, DM = 1024, FF = 2816, M = BATCH * SEQ, PLE = 256;
constexpr int NIN = 3840;
constexpr int NGATE = 2048;
constexpr float EPS = 1e-6f;
constexpr int NWAVES = 8, NTHREADS = 512;
constexpr int NPHASE = 19;

constexpr size_t MiB = 1u << 20;
constexpr size_t WS_CTL = 0, CTL_ZERO_BYTES = 1 * MiB;
constexpr size_t WS_W = 1 * MiB;
constexpr size_t W_GU1 = WS_W, W_D1 = W_GU1 + 11 * MiB, W_IN = W_D1 + 11 * MiB / 2, W_G = W_IN + 15 * MiB / 2, W_BRB = W_G + 4 * MiB,
                 W_UVBR = W_BRB + 1 * MiB, W_OUT = W_UVBR + 2 * MiB, W_GU2 = W_OUT + 2 * MiB, W_D2 = W_GU2 + 11 * MiB, W_PG = W_D2 + 11 * MiB / 2,
                 W_PP = W_PG + 2 * MiB, W_LB = W_PP + MiB / 2;
static_assert(W_LB + 4096 <= 54 * MiB, "weights region");
constexpr size_t WS_XN = 54 * MiB, WS_Y = 118 * MiB, WS_OH = 118 * MiB, WS_YB = 150 * MiB, WS_ACT = 182 * MiB;
constexpr size_t WS_QLAT = 182 * MiB, WS_QIDX = 246 * MiB, WS_QH = 278 * MiB, WS_IH = 310 * MiB, WS_GH = 342 * MiB, WS_LOGF = 374 * MiB,
                 WS_SMALL = 438 * MiB, WS_CKV = 470 * MiB, WS_KIDX = 478 * MiB, WS_WQ = 482 * MiB, WS_P16 = 483 * MiB;
constexpr size_t WS_G = 246 * MiB, WS_MERGED = 374 * MiB, WS_GP = 358 * MiB, WS_END = 512 * MiB;
constexpr int CW_BAR = 4096;

constexpr int RING_BYTES = 131072, WSM_OFF = 131072, WSM_BYTES = 2560, TAB_OFF = WSM_OFF + 8 * WSM_BYTES, LDSCTL_OFF = TAB_OFF + 3072, LDS_BYTES = 160 * 1024;
static_assert(LDSCTL_OFF + 512 <= LDS_BYTES, "LDS map");

struct Args { const float* in[30]; float* out; unsigned char* ws; int ph_lo, ph_hi; };

__device__ __forceinline__ float wave_sum(float v) {
#pragma unroll
    for (int o = 1; o < 64; o <<= 1) v += __shfl_xor(v, o);
    return v;
}
__device__ __forceinline__ float wave_max(float v) {
#pragma unroll
    for (int o = 1; o < 64; o <<= 1) v = fmaxf(v, __shfl_xor(v, o));
    return v;
}
__device__ __forceinline__ float sigmoidf_(float x) { return __builtin_amdgcn_rcpf(1.0f + __expf(-x)); }
__device__ __forceinline__ float siluf_(float x) { return x * sigmoidf_(x); }
__device__ __forceinline__ float dot8(f16x8 a, f16x8 b, float c) {
    c = __builtin_amdgcn_fdot2(__builtin_shufflevector(a, a, 0, 1), __builtin_shufflevector(b, b, 0, 1), c, false);
    c = __builtin_amdgcn_fdot2(__builtin_shufflevector(a, a, 2, 3), __builtin_shufflevector(b, b, 2, 3), c, false);
    c = __builtin_amdgcn_fdot2(__builtin_shufflevector(a, a, 4, 5), __builtin_shufflevector(b, b, 4, 5), c, false);
    c = __builtin_amdgcn_fdot2(__builtin_shufflevector(a, a, 6, 7), __builtin_shufflevector(b, b, 6, 7), c, false);
    return c;
}

typedef short bf16x8 __attribute__((ext_vector_type(8)));
typedef short s16x4 __attribute__((ext_vector_type(4)));
typedef __bf16 bf16x2_t __attribute__((ext_vector_type(2)));
__device__ __forceinline__ unsigned pk_bf16(float lo, float hi) { f32x2 v = {lo, hi}; bf16x2_t b = __builtin_convertvector(v, bf16x2_t); return __builtin_bit_cast(unsigned, b); }
__device__ __forceinline__ s16x4 lds_tr16(const LAS unsigned char* p) { return __builtin_bit_cast(s16x4, __builtin_amdgcn_ds_read_tr16_b64_v4i16((LAS s16x4*)p)); }
__device__ __forceinline__ bf16x8 cat44(s16x4 a, s16x4 b) { return __builtin_shufflevector(a, b, 0, 1, 2, 3, 4, 5, 6, 7); }
__device__ __forceinline__ bf16x8 pack_bf8(f32x4 a, f32x4 b) { u32x4 w; w[0] = pk_bf16(a[0], a[1]); w[1] = pk_bf16(a[2], a[3]); w[2] = pk_bf16(b[0], b[1]); w[3] = pk_bf16(b[2], b[3]); return __builtin_bit_cast(bf16x8, w); }
__device__ __forceinline__ unsigned off_b(unsigned row, unsigned ch) { return 256u * row + 16u * (ch ^ (((row & 3u) << 2) | ((row >> 2) & 3u))); }

__device__ __forceinline__ int wave_total_i(int v) {
    v += __builtin_amdgcn_mov_dpp(v, 0xB1, 0xF, 0xF, true);
    v += __builtin_amdgcn_mov_dpp(v, 0x4E, 0xF, 0xF, true);
    v += __builtin_amdgcn_mov_dpp(v, 0x141, 0xF, 0xF, true);
    v += __builtin_amdgcn_mov_dpp(v, 0x140, 0xF, 0xF, true);
    return __builtin_amdgcn_readlane(v, 0) + __builtin_amdgcn_readlane(v, 16) + __builtin_amdgcn_readlane(v, 32) + __builtin_amdgcn_readlane(v, 48);
}
#define LDS_WAIT() asm volatile("s_waitcnt lgkmcnt(0)" ::: "memory")
#define VM_WAIT() asm volatile("s_waitcnt vmcnt(0)" ::: "memory")

namespace pg8 {
constexpr int BM = 256, BK = 64, HALF = 128, HTB = HALF * BK * 2, STAGE_BYTES = 8 * HTB, NXCD = 8, WGM = 8;
__host__ __device__ __forceinline__ int lds_byte(int r, int c) { const int st = (r >> 4) * 2 + (c >> 5), rr = r & 15, cc = c & 31, ob = rr * 64 + cc * 2; return st * 1024 + (ob ^ (((ob >> 9) & 1) << 5)); }
__host__ __device__ __forceinline__ void stage_rc(int b, int& R, int& C) { const int st = b / 1024, sb = b % 1024, swz = sb ^ (((sb >> 9) & 1) << 5); R = (st >> 1) * 16 + swz / 64; C = (st & 1) * 32 + (swz % 64) / 2; }
__host__ __device__ __forceinline__ int perm32(int rho) { const int n = rho >> 4, i = rho & 15; return 8 * (i >> 2) + 4 * n + (i & 3); }
struct Unit { int pm, pn; };
struct Gemm { const f16* A; const f16* Bt; int M, N, K; };
struct StaticOrder {
    int nM, nN, nwg, G, c;
    __device__ void init(int M_, int N_, int G_, int c_) { nM = M_ / BM; nN = N_ / BM; nwg = nM * nN; G = G_; c = c_; }
    __device__ bool next(int i, Unit& u) const {
        const long L = (long)i * G + c; if (L >= nwg) return false;
        int wgid = (int)L; { const int q = nwg / NXCD, r = nwg % NXCD, xcd = wgid % NXCD, off = wgid / NXCD; wgid = (xcd < r ? xcd * (q + 1) : r * (q + 1) + (xcd - r) * q) + off; }
        const int nig = WGM * nN, gid = wgid / nig, fm = gid * WGM, gsz = (nM - fm) < WGM ? (nM - fm) : WGM;
        u.pm = fm + ((wgid % nig) % gsz); u.pn = (wgid % nig) / gsz; return true;
    }
};

enum { EP_SWIGLU = 0, EP_F16 = 1, EP_INPROJ = 2, EP_GATES = 3, EP_BRA = 4, EP_BRB = 5, EP_PLE1 = 6, EP_PLE2 = 7 };
__device__ __forceinline__ f16x8 pack8(f32x4 a, f32x4 b) { f16x8 w; w[0] = (f16)a[0]; w[1] = (f16)a[1]; w[2] = (f16)a[2]; w[3] = (f16)a[3]; w[4] = (f16)b[0]; w[5] = (f16)b[1]; w[6] = (f16)b[2]; w[7] = (f16)b[3]; return w; }
template <int MODE> struct Epi {
    f16* O; int ldc; const f16* Gt; const float* bias;
    f16 *qlat, *qidx, *qh, *ih, *gh; float *logf, *small; const float* lb;
    __device__ __forceinline__ void operator()(const f32x4 (&acc)[2][2][4][2], const Unit& u, int wr, int wc, int fr, int fq) const {
        const int row0 = u.pm * BM + wr * 64 + fr;
        if constexpr (MODE == EP_SWIGLU) {
            const int col = u.pn * 128 + wc * 32 + 8 * fq;
#pragma unroll
            for (int ai = 0; ai < 2; ++ai)
#pragma unroll
                for (int m = 0; m < 4; ++m) { const size_t row = row0 + ai * HALF + m * 16; f32x4 v[2];
#pragma unroll
                    for (int n = 0; n < 2; ++n)
#pragma unroll
                        for (int j = 0; j < 4; ++j) v[n][j] = siluf_(acc[ai][0][m][n][j]) * acc[ai][1][m][n][j];
                    *(f16x8*)(O + row * ldc + col) = pack8(v[0], v[1]); }
        } else {
            const int colb = u.pn * BM + wc * 32 + 8 * fq;
            f32x4 bv[2][2] = {{{0.f, 0.f, 0.f, 0.f}, {0.f, 0.f, 0.f, 0.f}}, {{0.f, 0.f, 0.f, 0.f}, {0.f, 0.f, 0.f, 0.f}}};
            if constexpr (MODE == EP_GATES) {
#pragma unroll
                for (int bj = 0; bj < 2; ++bj) { bv[bj][0] = *(const f32x4*)(bias + colb + bj * HALF); bv[bj][1] = *(const f32x4*)(bias + colb + bj * HALF + 4); } }
            if constexpr (MODE == EP_INPROJ) { if (u.pn == 8 || u.pn == 9) {
#pragma unroll
                for (int bj = 0; bj < 2; ++bj) { bv[bj][0] = *(const f32x4*)(lb + colb + bj * HALF - 2048); bv[bj][1] = *(const f32x4*)(lb + colb + bj * HALF - 2048 + 4); } } }
#pragma unroll
            for (int ai = 0; ai < 2; ++ai)
#pragma unroll
                for (int m = 0; m < 4; ++m) { const size_t row = row0 + ai * HALF + m * 16;
#pragma unroll
                    for (int bj = 0; bj < 2; ++bj) { const int col = colb + bj * HALF; f32x4 v0 = acc[ai][bj][m][0], v1 = acc[ai][bj][m][1];
                        if constexpr (MODE == EP_F16) { *(f16x8*)(O + row * ldc + col) = pack8(v0, v1); }
                        if constexpr (MODE == EP_GATES || MODE == EP_PLE1) {
#pragma unroll
                            for (int j = 0; j < 4; ++j) { v0[j] = sigmoidf_(v0[j] + bv[bj][0][j]); v1[j] = sigmoidf_(v1[j] + bv[bj][1][j]); }
                            *(f16x8*)(O + row * ldc + col) = pack8(v0, v1); }
                        if constexpr (MODE == EP_BRA || MODE == EP_BRB || MODE == EP_PLE2) {
                            const f16x8 g = *(const f16x8*)(Gt + row * (MODE == EP_PLE2 ? 1024 : 2048) + (MODE == EP_BRB ? 1024 : 0) + col);
#pragma unroll
                            for (int j = 0; j < 4; ++j) { v0[j] *= (float)g[j]; v1[j] *= (float)g[4 + j]; }
                            if constexpr (MODE == EP_BRB) { const f16x8 o = *(const f16x8*)(O + row * ldc + col);
#pragma unroll
                                for (int j = 0; j < 4; ++j) { v0[j] += (float)o[j]; v1[j] += (float)o[4 + j]; } }
                            *(f16x8*)(O + row * ldc + col) = pack8(v0, v1); }
                        if constexpr (MODE == EP_INPROJ) {
                            const int pn = u.pn;
                            if (pn < 4) { *(f16x8*)(qlat + row * 1024 + col) = pack8(v0, v1); }
                            else if (pn < 6) { *(f16x8*)(qidx + row * 512 + (col - 1024)) = pack8(v0, v1); }
                            else if (pn < 8) {
#pragma unroll
                                for (int j = 0; j < 4; ++j) { v0[j] = siluf_(v0[j]); v1[j] = siluf_(v1[j]); }
                                *(f16x8*)(qh + row * 512 + (col - 1536)) = pack8(v0, v1); }
                            else if (pn < 10) {
#pragma unroll
                                for (int j = 0; j < 4; ++j) { v0[j] = __logf(bv[bj][0][j] + (1.0f - bv[bj][0][j]) * sigmoidf_(v0[j])); v1[j] = __logf(bv[bj][1][j] + (1.0f - bv[bj][1][j]) * sigmoidf_(v1[j])); }
                                *(f32x4*)(logf + row * 512 + (col - 2048)) = v0; *(f32x4*)(logf + row * 512 + (col - 2048) + 4) = v1; }
                            else if (pn < 12) { *(f16x8*)(ih + row * 512 + (col - 2560)) = pack8(v0, v1); }
                            else if (pn < 14) {
#pragma unroll
                                for (int j = 0; j < 4; ++j) { v0[j] = siluf_(v0[j]); v1[j] = siluf_(v1[j]); }
                                *(f16x8*)(gh + row * 512 + (col - 3072)) = pack8(v0, v1); }
                            else { *(f32x4*)(small + row * 256 + (col - 3584)) = v0; *(f32x4*)(small + row * 256 + (col - 3584) + 4) = v1; }
                        }
                    }
                    if constexpr (MODE == EP_BRA || MODE == EP_BRB || MODE == EP_PLE2) asm volatile("" ::: "memory");
                }
        }
    }
};

template <class EpiT>
__device__ __forceinline__ void gemm_phase(LAS unsigned char* lds, const Gemm g, const StaticOrder& S, const EpiT& E) {
    const int tid = threadIdx.x, wid = __builtin_amdgcn_readfirstlane(tid >> 6), lane = tid & 63, wr = wid >> 2, wc = wid & 3, fr = lane & 15, fq = lane >> 4;
    const int K = g.K, nt = K / BK;
    unsigned voffA[2], voffB[2];
#pragma unroll
    for (int i = 0; i < 2; ++i) { int R, C; stage_rc(tid * 16 + i * 8192, R, C); const int Rb = (R & ~31) + perm32(R & 31);
        voffA[i] = (unsigned)(R * K + C) * 2u; voffB[i] = (unsigned)(Rb * K + C) * 2u; }
    const size_t kstep = (size_t)(BK * 2);
    const size_t hstep = (size_t)HALF * K * 2;
    const size_t tstep = 2 * hstep;
    const unsigned ldsw = (unsigned)wid * 1024u;
    const int aoff = lds_byte(wr * 64 + fr, fq * 8), boff = lds_byte(wc * 32 + fr, fq * 8);
#define PG8_SA(b, h) (((b) * 2 + (h)) * HTB)
#define PG8_SB(b, h) ((4 + (b) * 2 + (h)) * HTB)
#define PG8_STAGE(bufoff, gbase, voff) do { _Pragma("unroll") for (int _i = 0; _i < 2; ++_i) \
        __builtin_amdgcn_global_load_lds((const unsigned*)((const char*)(gbase) + (voff)[_i]), (LAS unsigned*)(lds + (bufoff) + ldsw + _i * 8192), 16, 0, 0); } while (0)
#define PG8_LDA(dst, b, h) do { _Pragma("unroll") for (int m = 0; m < 4; ++m) _Pragma("unroll") for (int k = 0; k < 2; ++k) dst[m][k] = *(const LAS f16x8*)(lds + PG8_SA(b, h) + aoff + m * 2048 + k * 1024); } while (0)
#define PG8_LDB(dst, b, h) do { _Pragma("unroll") for (int n = 0; n < 2; ++n) _Pragma("unroll") for (int k = 0; k < 2; ++k) dst[n][k] = *(const LAS f16x8*)(lds + PG8_SB(b, h) + boff + n * 2048 + k * 1024); } while (0)
#define PG8_MMA(ai, bj, At, Bt) do { __builtin_amdgcn_s_setprio(1); _Pragma("unroll") for (int m = 0; m < 4; ++m) _Pragma("unroll") for (int n = 0; n < 2; ++n) _Pragma("unroll") for (int k = 0; k < 2; ++k) \
        acc[ai][bj][m][n] = __builtin_amdgcn_mfma_f32_16x16x32_f16(Bt[n][k], At[m][k], acc[ai][bj][m][n], 0, 0, 0); __builtin_amdgcn_s_setprio(0); } while (0)
#define PG8_WAIT_V(n) asm volatile("s_waitcnt vmcnt(" #n ")" ::: "memory")
#define PG8_WAIT_L(n) asm volatile("s_waitcnt lgkmcnt(" #n ")" ::: "memory")
#define PG8_BAR __builtin_amdgcn_s_barrier()
#define PG8_SCHED __builtin_amdgcn_sched_barrier(0)
    Unit cur, nxt; int ui = 0;
    if (!S.next(0, cur)) return;
    f32x4 acc[2][2][4][2];
#pragma unroll
    for (int a = 0; a < 2; ++a)
#pragma unroll
        for (int b = 0; b < 2; ++b)
#pragma unroll
            for (int m = 0; m < 4; ++m)
#pragma unroll
                for (int n = 0; n < 2; ++n) acc[a][b][m][n] = (f32x4){0.f, 0.f, 0.f, 0.f};
    f16x8 At[4][2], B0[2][2], B1[2][2];
    const char* cA = (const char*)g.A + (size_t)cur.pm * tstep; const char* cB = (const char*)g.Bt + (size_t)cur.pn * tstep;
    PG8_STAGE(PG8_SB(0, 0), cB, voffB); PG8_STAGE(PG8_SB(0, 1), cB + hstep, voffB); PG8_STAGE(PG8_SA(0, 0), cA, voffA); PG8_STAGE(PG8_SA(0, 1), cA + hstep, voffA);
    if (wr == 1) PG8_BAR;
    PG8_WAIT_V(2); PG8_BAR;
    PG8_STAGE(PG8_SB(1, 0), cB + kstep, voffB); PG8_STAGE(PG8_SA(1, 0), cA + kstep, voffA); PG8_STAGE(PG8_SB(1, 1), cB + hstep + kstep, voffB);
    PG8_WAIT_V(6); PG8_BAR;
    for (;;) {
        const bool has_next = S.next(ui + 1, nxt);
        const char* nA = has_next ? (const char*)g.A + (size_t)nxt.pm * tstep : cA; const char* nB = has_next ? (const char*)g.Bt + (size_t)nxt.pn * tstep : cB;
        for (int t = 0; t < nt; t += 2) {
            const bool last = (t == nt - 2);
            const char* a1 = cA + (size_t)(t + 1) * kstep;
            const char* a2 = last ? nA : cA + (size_t)(t + 2) * kstep; const char* b2 = last ? nB : cB + (size_t)(t + 2) * kstep;
            const char* a3 = a2 + kstep; const char* b3 = b2 + kstep;
            PG8_LDB(B0, 0, 0); PG8_LDB(B1, 0, 1); PG8_SCHED; PG8_LDA(At, 0, 0); PG8_STAGE(PG8_SA(1, 1), a1 + hstep, voffA);
            PG8_WAIT_V(8); PG8_WAIT_L(0); PG8_BAR; PG8_MMA(0, 0, At, B0); PG8_MMA(0, 1, At, B1); PG8_BAR; PG8_SCHED;
            PG8_LDA(At, 0, 1); PG8_STAGE(PG8_SB(0, 0), b2, voffB); PG8_STAGE(PG8_SB(0, 1), b2 + hstep, voffB); PG8_STAGE(PG8_SA(0, 0), a2, voffA);
            PG8_WAIT_V(8); PG8_WAIT_L(0); PG8_BAR; PG8_MMA(1, 0, At, B0); PG8_MMA(1, 1, At, B1); PG8_BAR; PG8_SCHED;
            PG8_LDB(B0, 1, 0); PG8_LDB(B1, 1, 1); PG8_SCHED; PG8_LDA(At, 1, 0); PG8_STAGE(PG8_SA(0, 1), a2 + hstep, voffA);
            PG8_WAIT_V(8); PG8_WAIT_L(0); PG8_BAR; PG8_MMA(0, 0, At, B0); PG8_MMA(0, 1, At, B1); PG8_BAR; PG8_SCHED;
            PG8_LDA(At, 1, 1); PG8_STAGE(PG8_SB(1, 0), b3, voffB); PG8_STAGE(PG8_SB(1, 1), b3 + hstep, voffB); PG8_STAGE(PG8_SA(1, 0), a3, voffA);
            PG8_WAIT_V(8); PG8_WAIT_L(0); PG8_BAR; PG8_MMA(1, 0, At, B0); PG8_MMA(1, 1, At, B1); PG8_BAR; PG8_SCHED;
        }
        if (wr == 0) PG8_BAR;
        E(acc, cur, wr, wc, fr, fq);
        if (!has_next) break;
#pragma unroll
        for (int a = 0; a < 2; ++a)
#pragma unroll
            for (int b = 0; b < 2; ++b)
#pragma unroll
                for (int m = 0; m < 4; ++m)
#pragma unroll
                    for (int n = 0; n < 2; ++n) acc[a][b][m][n] = (f32x4){0.f, 0.f, 0.f, 0.f};
        cur = nxt; cA = nA; cB = nB; ++ui;
        if (wr == 1) PG8_BAR;
    }
    PG8_WAIT_V(0);
    PG8_BAR;
#undef PG8_SA
#undef PG8_SB
#undef PG8_STAGE
#undef PG8_LDA
#undef PG8_LDB
#undef PG8_MMA
#undef PG8_WAIT_V
#undef PG8_WAIT_L
#undef PG8_BAR
#undef PG8_SCHED
}
}

#define XB_TMO      128
#define XB_XCNT(j)  (256  + 64 * (j))
#define XB_XSUB(j)  (1280 + 64 * (j))
#define XB_XGEN(j)  (2304 + 64 * (j))
#define XB_TOP      3328
#define XB_TOPGEN   3392
#define XCD_BAR_WORDS 3456
#define XB_SPIN_CAP (1u << 23)
__device__ __forceinline__ unsigned xb_ld(unsigned* p)              { return __hip_atomic_load(p, __ATOMIC_RELAXED, __HIP_MEMORY_SCOPE_AGENT); }
__device__ __forceinline__ unsigned xb_add(unsigned* p, unsigned v) { return __hip_atomic_fetch_add(p, v, __ATOMIC_RELAXED, __HIP_MEMORY_SCOPE_AGENT); }
__device__ __forceinline__ unsigned xb_xcc_id() { return (unsigned)__builtin_amdgcn_s_getreg((3 << 11) | 20) & 0xFu; }
#define XB_SPIN(cond, bar) do { unsigned _sp = 0; while (cond) { __builtin_amdgcn_s_sleep(1); \
    if ((++_sp & 255u) == 0u) { if (xb_ld(&(bar)[XB_TMO])) break; if (_sp > XB_SPIN_CAP) { atomicAdd(&(bar)[XB_TMO], 1u); break; } } } } while (0)
struct XcdBarrier { unsigned* bar; unsigned x; volatile LAS unsigned* st; };
__device__ __forceinline__ XcdBarrier xcd_barrier_post(unsigned* bar, volatile LAS unsigned* st) {
    XcdBarrier b; b.bar = bar; b.x = xb_xcc_id(); b.st = st;
    if (threadIdx.x == 0) (void)xb_add(&bar[XB_XCNT(b.x)], 1u);
    return b;
}
__device__ __forceinline__ void xcd_barrier_complete(unsigned* bar, unsigned x, unsigned& nloc, unsigned& nx) {
    const unsigned G = gridDim.x * gridDim.y * gridDim.z;
    unsigned sum, cnt, mine, sp = 0u;
    for (;;) {
        sum = 0u; cnt = 0u; mine = 0u;
#pragma unroll
        for (unsigned j = 0; j < 16; ++j) { const unsigned c = xb_ld(&bar[XB_XCNT(j)]); sum += c; cnt += (c > 0u) ? 1u : 0u; mine = (j == x) ? c : mine; }
        if (sum == G) break;
        __builtin_amdgcn_s_sleep(1);
        if ((++sp & 255u) == 0u) { if (xb_ld(&bar[XB_TMO])) break; if (sp > XB_SPIN_CAP) { atomicAdd(&bar[XB_TMO], 1u); break; } }
    }
    nloc = mine > 0u ? mine : 1u; nx = cnt > 0u ? cnt : 1u;
}
__device__ __forceinline__ void xcd_barrier(const XcdBarrier& b) {
    asm volatile("s_waitcnt vmcnt(0)" ::: "memory");
    __syncthreads();
    if (threadIdx.x == 0) {
        unsigned* bar = b.bar;
        __builtin_amdgcn_s_waitcnt(0);
        unsigned nloc = b.st[0], nx = b.st[1];
        if (nloc == 0u) { xcd_barrier_complete(bar, b.x, nloc, nx); b.st[0] = nloc; b.st[1] = nx; }
        const unsigned old = xb_add(&bar[XB_XSUB(b.x)], 1u);
        const unsigned gen = old / nloc;
        if (old + 1u == (gen + 1u) * nloc) {
            __builtin_amdgcn_fence(__ATOMIC_RELEASE, "agent");
            asm volatile("s_waitcnt vmcnt(0)" ::: "memory");
            const unsigned og = xb_add(&bar[XB_TOP], 1u);
            const unsigned tg = og / nx;
            if (og + 1u == (tg + 1u) * nx) xb_add(&bar[XB_TOPGEN], 1u);
            else XB_SPIN(xb_ld(&bar[XB_TOPGEN]) == tg, bar);
            __builtin_amdgcn_fence(__ATOMIC_ACQUIRE, "agent");
            xb_add(&bar[XB_XGEN(b.x)], 1u);
            asm volatile("s_waitcnt vmcnt(0)" ::: "memory");
        } else {
            XB_SPIN(xb_ld(&bar[XB_XGEN(b.x)]) == gen, bar);
            __builtin_amdgcn_fence(__ATOMIC_ACQUIRE, "agent");
            asm volatile("s_waitcnt vmcnt(0)" ::: "memory");
        }
    }
    __syncthreads();
}

struct TJ { int in, ldn, col0, K; unsigned long long dst; int row0, ncols, nvalid, il; };
constexpr int NTJ = 21;
__constant__ TJ tjobs[NTJ] = {
    {6, FF, 0, DM, W_GU1, 0, FF, FF, 1},      {7, FF, 0, DM, W_GU1, 128, FF, FF, 1},   {8, DM, 0, FF, W_D1, 0, DM, DM, 0},
    {23, FF, 0, DM, W_GU2, 0, FF, FF, 1},     {24, FF, 0, DM, W_GU2, 128, FF, FF, 1},  {25, DM, 0, FF, W_D2, 0, DM, DM, 0},
    {11, 5320, 640, DM, W_IN, 1024, 512, 512, 0},  {11, 5320, 1224, DM, W_IN, 1536, 512, 512, 0}, {11, 5320, 1736, DM, W_IN, 2048, 512, 512, 0},
    {11, 5320, 2248, DM, W_IN, 2560, 512, 512, 0}, {11, 5320, 2760, DM, W_IN, 3072, 512, 512, 0}, {11, 5320, 512, DM, W_IN, 3584, 128, 128, 0},
    {11, 5320, 1152, DM, W_IN, 3712, 64, 64, 0},   {11, 5320, 1216, DM, W_IN, 3776, 32, 8, 0},    {11, 5320, 0, DM, W_IN, 3808, 32, 0, 0},
    {11, 5320, 3272, DM, W_G, 0, 1024, 1024, 0},   {11, 5320, 4296, DM, W_G, 1024, 1024, 1024, 0},
    {18, DM, 0, 512, W_BRB, 0, DM, DM, 0},    {20, DM, 0, DM, W_OUT, 0, DM, DM, 0},    {28, DM, 0, DM, W_PG, 0, DM, DM, 0},      {29, DM, 0, PLE, W_PP, 0, DM, DM, 0},
};
__device__ __forceinline__ void transpose_item(const float* W, int ldn, int col0, int K, f16* WT, int row0, int nvalid, int il, LAS float* scr, int item, int ncols, int lane) {
    const int nblk = ncols / 32, kb = item / nblk, nb = item % nblk, k0 = 64 * kb, n0 = 32 * nb;
#pragma unroll
    for (int i = 0; i < 32; ++i) { const int kk = 2 * i + (lane >> 5); scr[kk * 33 + (lane & 31)] = W[(size_t)(k0 + kk) * ldn + col0 + n0 + (lane & 31)]; }
    LDS_WAIT();
    const int c = lane & 7;
#pragma unroll
    for (int j = 0; j < 4; ++j) { const int n = (lane >> 3) + 8 * j; const LAS float* s = scr + (8 * c) * 33 + n;
        f16x8 o;
#pragma unroll
        for (int e = 0; e < 8; ++e) o[e] = (n0 + n < nvalid) ? (f16)s[e * 33] : (f16)0.f;
        const int nn = n0 + n; const int drow = il ? (row0 + 256 * (nn >> 7) + (nn & 127)) : (row0 + nn);
        *(f16x8*)(WT + (size_t)drow * K + k0 + 8 * c) = o; }
    LDS_WAIT();
}

template <bool HIN16, bool HOUT16>
__device__ __forceinline__ void row_update2(const void* hin_, size_t hin_pitch, const f16* y, const float* gpost, float scale, void* hout_, size_t hout_pitch, const float* gnext, f16* xn, int lane) {
    f32x4 h[2][4], yv[2][4]; float ss[2] = {0.f, 0.f};
#pragma unroll
    for (int rr = 0; rr < 2; ++rr)
#pragma unroll
        for (int j = 0; j < 4; ++j) { const int c = (lane + 64 * j) * 4; const f16x4 t = *(const f16x4*)(y + rr * DM + c); yv[rr][j] = (f32x4){(float)t[0], (float)t[1], (float)t[2], (float)t[3]};
            if constexpr (HIN16) { const f16x4 hh = *(const f16x4*)((const f16*)hin_ + rr * hin_pitch + c); h[rr][j] = (f32x4){(float)hh[0], (float)hh[1], (float)hh[2], (float)hh[3]}; } else h[rr][j] = *(const f32x4*)((const float*)hin_ + rr * hin_pitch + c); }
#pragma unroll
    for (int rr = 0; rr < 2; ++rr)
#pragma unroll
        for (int j = 0; j < 4; ++j) ss[rr] += (yv[rr][j][0] * yv[rr][j][0] + yv[rr][j][1] * yv[rr][j][1]) + (yv[rr][j][2] * yv[rr][j][2] + yv[rr][j][3] * yv[rr][j][3]);
    float s2[2] = {0.f, 0.f};
#pragma unroll
    for (int rr = 0; rr < 2; ++rr) {
        const float rstd = scale * __builtin_amdgcn_rsqf(wave_sum(ss[rr]) * (1.f / DM) + EPS);
#pragma unroll
        for (int j = 0; j < 4; ++j) { const int c = (lane + 64 * j) * 4; const f32x4 g = *(const f32x4*)(gpost + c); h[rr][j] = h[rr][j] + yv[rr][j] * rstd * g;
            s2[rr] += (h[rr][j][0] * h[rr][j][0] + h[rr][j][1] * h[rr][j][1]) + (h[rr][j][2] * h[rr][j][2] + h[rr][j][3] * h[rr][j][3]);
            if constexpr (HOUT16) { f16x4 w; w[0] = (f16)h[rr][j][0]; w[1] = (f16)h[rr][j][1]; w[2] = (f16)h[rr][j][2]; w[3] = (f16)h[rr][j][3]; *(f16x4*)((f16*)hout_ + rr * hout_pitch + c) = w; }
            else *(f32x4*)((float*)hout_ + rr * hout_pitch + c) = h[rr][j]; }
    }
    if (gnext) {
#pragma unroll
        for (int rr = 0; rr < 2; ++rr) {
            const float r2 = __builtin_amdgcn_rsqf(wave_sum(s2[rr]) * (1.f / DM) + EPS);
#pragma unroll
            for (int j = 0; j < 4; ++j) { const int c = (lane + 64 * j) * 4; const f32x4 g = *(const f32x4*)(gnext + c); const f32x4 o = h[rr][j] * r2 * g;
                f16x4 w; w[0] = (f16)o[0]; w[1] = (f16)o[1]; w[2] = (f16)o[2]; w[3] = (f16)o[3]; *(f16x4*)(xn + rr * DM + c) = w; }
        }
    }
}

__global__ void __launch_bounds__(NTHREADS, 2) mk_fwd(Args args_unused) {
    extern __shared__ __attribute__((aligned(16))) unsigned char lds_raw[];
    LAS unsigned char* lds = (LAS unsigned char*)lds_raw;
    const int tid = threadIdx.x, lane = tid & 63, wave = __builtin_amdgcn_readfirstlane(tid >> 6);
    const int G = gridDim.x; const int bx = blockIdx.x; const int vcu = (G % 8 == 0) ? (bx % 8) * (G / 8) + bx / 8 : bx;
    const int gw = vcu * NWAVES + wave, NGW = G * NWAVES;
    typedef const __attribute__((address_space(4))) Args* CArgsP;
    const CArgsP ap0 = (CArgsP)__builtin_amdgcn_kernarg_segment_ptr();
    unsigned* ctl = (unsigned*)(ap0->ws + WS_CTL);
    volatile LAS unsigned* MISC = (volatile LAS unsigned*)(lds + LDSCTL_OFF);
    for (int u = tid; u < 128; u += NTHREADS) MISC[u] = 0u;
    __syncthreads();
    const int lo = ap0->ph_lo, hi = ap0->ph_hi;
    XcdBarrier bar; bar.bar = ctl + CW_BAR; bar.x = 0; bar.st = nullptr;
    if (hi - lo > 1) bar = xcd_barrier_post(ctl + CW_BAR, MISC + 8);
#ifndef MK_PHASE_MASK
#define MK_PHASE_MASK 0xFFFFFFFFu
#endif
#define IN(k) ((((MK_PHASE_MASK) >> (k)) & 1u) && lo <= (k) && (k) < hi)
#ifndef MK_REP_MASK
#define MK_REP_MASK 0u
#endif
#define REPS(k) ((((MK_REP_MASK) >> (k)) & 1u) ? 2 : 1)
#define SEAM(k) do { if (IN(k) && IN((k) + 1)) xcd_barrier(bar); } while (0)

#define PH_BEGIN() CArgsP ap = ap0; asm volatile("" : "+s"(ap)); const __attribute__((address_space(4))) Args& args = *ap; unsigned char* const ws = args.ws; (void)ws; \
    f16* const XN = (f16*)(ws + WS_XN); f16* const Y = (f16*)(ws + WS_Y); f16* const ACT = (f16*)(ws + WS_ACT); \
    f16* const QLAT = (f16*)(ws + WS_QLAT); f16* const QIDX = (f16*)(ws + WS_QIDX); f16* const QH = (f16*)(ws + WS_QH); f16* const IH = (f16*)(ws + WS_IH); \
    f16* const GH = (f16*)(ws + WS_GH); float* const LOGF = (float*)(ws + WS_LOGF); float* const SMALL = (float*)(ws + WS_SMALL); \
    f16* const CKV = (f16*)(ws + WS_CKV); f16* const KIDX = (f16*)(ws + WS_KIDX); float* const WQ = (float*)(ws + WS_WQ); f16* const P16 = (f16*)(ws + WS_P16); \
    f16* const OH = (f16*)(ws + WS_OH); f16* const YB = (f16*)(ws + WS_YB); f16* const GT = (f16*)(ws + WS_G); f16* const MERGED = (f16*)(ws + WS_MERGED); f16* const GP = (f16*)(ws + WS_GP); \
    float* const LB = (float*)(ws + W_LB); float* const HOUT = args.out; \
    (void)XN; (void)Y; (void)ACT; (void)QLAT; (void)QIDX; (void)QH; (void)IH; (void)GH; (void)LOGF; (void)SMALL; (void)CKV; (void)KIDX; (void)WQ; (void)P16; (void)OH; (void)YB; (void)GT; (void)MERGED; (void)GP; (void)LB; (void)HOUT;

    if (IN(0)) for (int rep_ = 0; rep_ < REPS(0); ++rep_) { PH_BEGIN();
        {
            LAS float* wl = (LAS float*)(lds + 98304);
            const bool isq = vcu < 128; const int v2 = isq ? vcu : vcu - 128; const int h = v2 >> 4; const int idx = (v2 & 15) * 64 + lane;
            const float* src = (isq ? args.in[14] : args.in[15]) + (size_t)h * 128 * 64;
            if (vcu < 256) { for (int i = tid; i < 128 * 64 / 4; i += NTHREADS) ((LAS f32x4*)wl)[i] = ((const f32x4*)src)[i]; }
            LDS_WAIT(); __syncthreads();
            if (vcu < 256) {
                float a[64];
                if (isq) {
                    const float* win = args.in[11] + (size_t)idx * 5320 + h * 64;
#pragma unroll
                    for (int d = 0; d < 64; ++d) a[d] = win[d];
                    f16* dst = (f16*)(ws + W_IN);
                    for (int c = 16 * wave; c < 16 * wave + 16; ++c) { float s = 0.f;
#pragma unroll
                        for (int d = 0; d < 64; ++d) s += a[d] * wl[c * 64 + d];
                        dst[(size_t)(h * 128 + c) * DM + idx] = (f16)s; }
                } else {
                    const float* wb = args.in[17] + (size_t)(h * 64) * DM + idx;
#pragma unroll
                    for (int d = 0; d < 64; ++d) a[d] = wb[(size_t)d * DM];
                    f16* dst = (f16*)(ws + W_UVBR) + (size_t)idx * DM + h * 128;
                    for (int c8 = 2 * wave; c8 < 2 * wave + 2; ++c8) { f16x8 o;
#pragma unroll
                        for (int e = 0; e < 8; ++e) { float s = 0.f; const int c = c8 * 8 + e;
#pragma unroll
                            for (int d = 0; d < 64; ++d) s += a[d] * wl[c * 64 + d];
                            o[e] = (f16)s; }
                        *(f16x8*)(dst + c8 * 8) = o; }
                }
            }
        }
        if (vcu == 32 && tid < 512) { const float a0 = args.in[3][tid], a1 = args.in[3][512 + tid]; LB[tid] = 1.0f / (1.0f + __expf(a1 - a0)); }
        LAS float* scr = (LAS float*)(lds + wave * 8704);
        int tot = 0;
        for (int j = 0; j < NTJ; ++j) tot += (tjobs[j].K / 64) * (tjobs[j].ncols / 32);
        for (int it = gw; it < tot; it += NGW) {
            int r = it, j = 0;
            for (; j < NTJ; ++j) { const int n = (tjobs[j].K / 64) * (tjobs[j].ncols / 32); if (r < n) break; r -= n; }
            const TJ t = tjobs[j];
            transpose_item(args.in[t.in], t.ldn, t.col0, t.K, (f16*)(ws + t.dst), t.row0, t.nvalid, t.il, scr, r, t.ncols, lane);
        }
        for (int m0 = 2 * gw; m0 < M; m0 += 2 * NGW) {
            f32x4 v[2][4]; f32x4 pv[2]; float ss[2] = {0.f, 0.f};
#pragma unroll
            for (int rr = 0; rr < 2; ++rr) { const float* xr = args.in[0] + (size_t)(m0 + rr) * DM;
#pragma unroll
                for (int j = 0; j < 4; ++j) v[rr][j] = *(const f32x4*)(xr + (lane + 64 * j) * 4);
                pv[rr] = *(const f32x4*)(args.in[1] + (size_t)(m0 + rr) * PLE + lane * 4); }
#pragma unroll
            for (int rr = 0; rr < 2; ++rr)
#pragma unroll
                for (int j = 0; j < 4; ++j) ss[rr] += (v[rr][j][0] * v[rr][j][0] + v[rr][j][1] * v[rr][j][1]) + (v[rr][j][2] * v[rr][j][2] + v[rr][j][3] * v[rr][j][3]);
#pragma unroll
            for (int rr = 0; rr < 2; ++rr) { const int m = m0 + rr;
                const float rstd = __builtin_amdgcn_rsqf(wave_sum(ss[rr]) * (1.f / DM) + EPS);
#pragma unroll
                for (int j = 0; j < 4; ++j) { const int c = (lane + 64 * j) * 4; const f32x4 g = *(const f32x4*)(args.in[4] + c); const f32x4 o = v[rr][j] * rstd * g;
                    f16x4 w; w[0] = (f16)o[0]; w[1] = (f16)o[1]; w[2] = (f16)o[2]; w[3] = (f16)o[3]; *(f16x4*)(XN + (size_t)m * DM + c) = w; }
                f16x4 w; w[0] = (f16)pv[rr][0]; w[1] = (f16)pv[rr][1]; w[2] = (f16)pv[rr][2]; w[3] = (f16)pv[rr][3]; *(f16x4*)(P16 + (size_t)m * PLE + lane * 4) = w; }
        }
    }
    SEAM(0);
    if (IN(1)) for (int rep_ = 0; rep_ < REPS(1); ++rep_) { PH_BEGIN(); pg8::Gemm g{XN, (const f16*)(ws + W_GU1), M, 2 * FF, DM}; pg8::StaticOrder S; S.init(M, 2 * FF, G, bx);
        pg8::Epi<pg8::EP_SWIGLU> E{}; E.O = ACT; E.ldc = FF; pg8::gemm_phase(lds, g, S, E); }
    SEAM(1);
    if (IN(2)) for (int rep_ = 0; rep_ < REPS(2); ++rep_) { PH_BEGIN(); pg8::Gemm g{ACT, (const f16*)(ws + W_D1), M, DM, FF}; pg8::StaticOrder S; S.init(M, DM, G, bx);
        pg8::Epi<pg8::EP_F16> E{}; E.O = Y; E.ldc = DM; pg8::gemm_phase(lds, g, S, E); }
    SEAM(2);
    if (IN(3)) for (int rep_ = 0; rep_ < REPS(3); ++rep_) { PH_BEGIN(); for (int m = 2 * gw; m < M; m += 2 * NGW) row_update2<false, true>(args.in[0] + (size_t)m * DM, DM, Y + (size_t)m * DM, args.in[5], 0.5f, (f16*)HOUT + (size_t)m * 2048 + 1024, 2048, args.in[9], XN + (size_t)m * DM, lane); }
    SEAM(3);
    if (IN(4)) for (int rep_ = 0; rep_ < REPS(4); ++rep_) { PH_BEGIN(); pg8::Gemm g{XN, (const f16*)(ws + W_IN), M, NIN, DM}; pg8::StaticOrder S; S.init(M, NIN, G, bx);
        pg8::Epi<pg8::EP_INPROJ> E{}; E.qlat = QLAT; E.qidx = QIDX; E.qh = QH; E.ih = IH; E.gh = GH; E.logf = LOGF; E.small = SMALL; E.lb = LB; pg8::gemm_phase(lds, g, S, E); }
    SEAM(4);
    if (IN(5)) for (int rep_ = 0; rep_ < REPS(5); ++rep_) { PH_BEGIN();
        for (int m = gw; m < M; m += NGW) {
            const float* sr = SMALL + (size_t)m * 256;
            const f32x2 c2 = *(const f32x2*)(sr + 2 * lane); const float k1 = sr[128 + lane];
            const float rc = __builtin_amdgcn_rsqf(wave_sum(c2[0] * c2[0] + c2[1] * c2[1]) * (1.f / 128.f) + EPS);
            const float rk = __builtin_amdgcn_rsqf(wave_sum(k1 * k1) * (1.f / 64.f) + EPS);
            const f32x2 gc = *(const f32x2*)(args.in[12] + 2 * lane);
            f16x2 o; o[0] = (f16)(c2[0] * rc * gc[0]); o[1] = (f16)(c2[1] * rc * gc[1]); *(f16x2*)(CKV + (size_t)m * 128 + 2 * lane) = o;
            KIDX[(size_t)m * 64 + lane] = (f16)(k1 * rk * args.in[13][lane]);
            if (lane < 8) WQ[(size_t)m * 8 + lane] = sr[192 + lane] * 0.04419417382415922f;
        }
    }
    SEAM(5);
    if (IN(6)) for (int rep_ = 0; rep_ < REPS(6); ++rep_) { PH_BEGIN();
        constexpr int H_GF = 0, H_TOT = 16384, H_QS = 18432, H_Q1 = 26624, H_K0 = 30720, H_K1 = 34816, H_KST = 43008, H_V = 51200, H_D = 59392, H_GB = 59904, H_SS = 60928;
        float* const SSEG = (float*)(ws + WS_SMALL); float* const LSEG = (float*)(ws + WS_SMALL + 16 * MiB);
        const int t = tid >> 4, ch = tid & 15, fr = lane & 15, fg = lane >> 4, q_ = fr >> 2, p_ = fr & 3;
#define HG_CUMSUM() do { const int k_ = tid & 127, part_ = tid >> 7; LAS float* gf_ = (LAS float*)(lds + H_GF) + (8 * part_) * 128 + k_; float acc_ = 0.f; \
            _Pragma("unroll") for (int i_ = 0; i_ < 8; ++i_) { acc_ += gf_[i_ * 128]; gf_[i_ * 128] = acc_; } ((LAS float*)(lds + H_TOT))[part_ * 128 + k_] = acc_; } while (0)
#define HG_STORE(base, row, arr) do { u32x4 w_; w_[0] = pk_bf16(arr[0], arr[1]); w_[1] = pk_bf16(arr[2], arr[3]); w_[2] = pk_bf16(arr[4], arr[5]); w_[3] = pk_bf16(arr[6], arr[7]); *(LAS u32x4*)(lds + (base) + off_b((row), ch)) = w_; } while (0)
        for (int unit = vcu; unit < 256; unit += G) {
            const int bh = unit >> 3, seg = unit & 7, b = bh >> 2, h = bh & 3;
            const size_t rowbase = (size_t)b * SEQ * 512 + (size_t)seg * 512 * 512 + h * 128;
            f32x4 S[8];
#pragma unroll
            for (int m = 0; m < 8; ++m) S[m] = (f32x4){0.f, 0.f, 0.f, 0.f};
            if (tid < 128) ((LAS float*)(lds + H_GB))[tid] = 0.f;
            f32x4 ga, gb; f16x8 qv, vv;
            { const size_t ro = rowbase + (size_t)t * 512 + 8 * ch; ga = *(const f32x4*)(LOGF + ro); gb = *(const f32x4*)(LOGF + ro + 4); qv = *(const f16x8*)(QH + ro); vv = *(const f16x8*)(IH + ro); }
            for (int c = 0; c < 16; ++c) {
                *(LAS f32x4*)(lds + H_GF + t * 512 + ch * 32) = ga; *(LAS f32x4*)(lds + H_GF + t * 512 + ch * 32 + 16) = gb;
                { float vf[8];
#pragma unroll
                  for (int j = 0; j < 8; ++j) vf[j] = (float)vv[j];
                  HG_STORE(H_V, t, vf); }
                const f32x4 g0 = ga, g1 = gb; const f16x8 q8r = qv;
                if (c + 1 < 16) { const size_t ro = rowbase + (size_t)(32 * (c + 1) + t) * 512 + 8 * ch; ga = *(const f32x4*)(LOGF + ro); gb = *(const f32x4*)(LOGF + ro + 4); qv = *(const f16x8*)(QH + ro); vv = *(const f16x8*)(IH + ro); }
                LDS_WAIT(); __syncthreads();
                HG_CUMSUM();
                LDS_WAIT(); __syncthreads();
                {
                    const LAS float* gfr = (const LAS float*)(lds + H_GF); const LAS float* tot = (const LAS float*)(lds + H_TOT);
                    f32x4 G0 = *(const LAS f32x4*)(gfr + t * 128 + 8 * ch), G1 = *(const LAS f32x4*)(gfr + t * 128 + 8 * ch + 4);
                    const f32x4 t0a = *(const LAS f32x4*)(tot + 8 * ch), t0b = *(const LAS f32x4*)(tot + 8 * ch + 4);
                    const f32x4 t1a = *(const LAS f32x4*)(tot + 128 + 8 * ch), t1b = *(const LAS f32x4*)(tot + 128 + 8 * ch + 4);
                    const f32x4 t2a = *(const LAS f32x4*)(tot + 256 + 8 * ch), t2b = *(const LAS f32x4*)(tot + 256 + 8 * ch + 4);
                    const int part = t >> 3;
                    if (part >= 1) { G0 += t0a; G1 += t0b; } if (part >= 2) { G0 += t1a; G1 += t1b; } if (part >= 3) { G0 += t2a; G1 += t2b; }
                    const f32x4 G15a = *(const LAS f32x4*)(gfr + 15 * 128 + 8 * ch) + t0a, G15b = *(const LAS f32x4*)(gfr + 15 * 128 + 8 * ch + 4) + t0b;
                    const f32x4 GLa = *(const LAS f32x4*)(gfr + 31 * 128 + 8 * ch) + t0a + t1a + t2a, GLb = *(const LAS f32x4*)(gfr + 31 * 128 + 8 * ch + 4) + t0b + t1b + t2b;
                    float Gv[8], G15[8], GL[8], gr[8], qf[8];
#pragma unroll
                    for (int j = 0; j < 4; ++j) { Gv[j] = G0[j]; Gv[4 + j] = G1[j]; G15[j] = G15a[j]; G15[4 + j] = G15b[j]; GL[j] = GLa[j]; GL[4 + j] = GLb[j]; gr[j] = g0[j]; gr[4 + j] = g1[j]; }
#pragma unroll
                    for (int j = 0; j < 8; ++j) qf[j] = (float)q8r[j];
                    float qs[8], kst[8], x1[8], x2[8];
#pragma unroll
                    for (int j = 0; j < 8; ++j) { const float kk = 1.0f - __expf(gr[j]);
                        qs[j] = qf[j] * __expf(Gv[j]); kst[j] = kk * __expf(GL[j] - Gv[j]);
                        if (t < 16) { x1[j] = kk * __expf(fminf(-Gv[j], 80.f)); x2[j] = kk * __expf(G15[j] - Gv[j]); }
                        else { x1[j] = qf[j] * __expf(Gv[j] - G15[j]); x2[j] = kk * __expf(fminf(G15[j] - Gv[j], 80.f)); } }
                    HG_STORE(H_QS, t, qs); HG_STORE(H_KST, t, kst); HG_STORE(H_K1, t, x2);
                    if (t < 16) HG_STORE(H_K0, t, x1); else HG_STORE(H_Q1, t - 16, x1);
                    if (t == 0) { f32x4 d0, d1; LAS float* gbp = (LAS float*)(lds + H_GB) + 8 * ch;
#pragma unroll
                        for (int j = 0; j < 4; ++j) { d0[j] = __expf(GL[j]); d1[j] = __expf(GL[4 + j]); gbp[j] += GL[j]; gbp[4 + j] += GL[4 + j]; }
                        *(LAS f32x4*)(lds + H_D + 32 * ch) = d0; *(LAS f32x4*)(lds + H_D + 32 * ch + 16) = d1; }
                }
                LDS_WAIT(); __syncthreads();
                {
                    f32x4 at00 = {0.f, 0.f, 0.f, 0.f}, at10 = at00, at11 = at00;
#pragma unroll
                    for (int ks = 0; ks < 4; ++ks) {
                        const bf16x8 k0f = *(const LAS bf16x8*)(lds + H_K0 + off_b(fr, 4 * ks + fg)), q0f = *(const LAS bf16x8*)(lds + H_QS + off_b(fr, 4 * ks + fg));
                        const bf16x8 k1a = *(const LAS bf16x8*)(lds + H_K1 + off_b(fr, 4 * ks + fg)), k1b = *(const LAS bf16x8*)(lds + H_K1 + off_b(16 + fr, 4 * ks + fg));
                        const bf16x8 q1f = *(const LAS bf16x8*)(lds + H_Q1 + off_b(fr, 4 * ks + fg));
                        at00 = __builtin_amdgcn_mfma_f32_16x16x32_bf16(k0f, q0f, at00, 0, 0, 0);
                        at10 = __builtin_amdgcn_mfma_f32_16x16x32_bf16(k1a, q1f, at10, 0, 0, 0);
                        at11 = __builtin_amdgcn_mfma_f32_16x16x32_bf16(k1b, q1f, at11, 0, 0, 0);
                    }
#pragma unroll
                    for (int r = 0; r < 4; ++r) { if (4 * fg + r > fr) { at00[r] = 0.f; at11[r] = 0.f; } }
                    const unsigned vco = (unsigned)(2 * wave + (p_ >> 1)), vbo = 8u * (unsigned)(p_ & 1);
                    const bf16x8 vt = cat44(lds_tr16(lds + H_V + off_b(4 * fg + q_, vco) + vbo), lds_tr16(lds + H_V + off_b(16 + 4 * fg + q_, vco) + vbo));
                    const f32x4 z = {0.f, 0.f, 0.f, 0.f};
                    f32x4 oi[2];
                    oi[0] = __builtin_amdgcn_mfma_f32_16x16x32_bf16(vt, pack_bf8(at00, z), z, 0, 0, 0);
                    oi[1] = __builtin_amdgcn_mfma_f32_16x16x32_bf16(vt, pack_bf8(at10, at11), z, 0, 0, 0);
#pragma unroll
                    for (int ks = 0; ks < 4; ++ks) {
                        const bf16x8 sop = pack_bf8(S[2 * ks], S[2 * ks + 1]);
#pragma unroll
                        for (int blk = 0; blk < 2; ++blk) {
                            const s16x4 qa = *(const LAS s16x4*)(lds + H_QS + off_b(16 * blk + fr, 4 * ks + (fg >> 1)) + 8 * (fg & 1));
                            const s16x4 qb = *(const LAS s16x4*)(lds + H_QS + off_b(16 * blk + fr, 4 * ks + 2 + (fg >> 1)) + 8 * (fg & 1));
                            oi[blk] = __builtin_amdgcn_mfma_f32_16x16x32_bf16(sop, cat44(qa, qb), oi[blk], 0, 0, 0);
                        }
                    }
                    const bf16x8 vb = cat44(lds_tr16(lds + H_V + off_b(8 * fg + q_, vco) + vbo), lds_tr16(lds + H_V + off_b(8 * fg + 4 + q_, vco) + vbo));
#pragma unroll
                    for (int m = 0; m < 8; ++m) {
                        const bf16x8 ka = cat44(lds_tr16(lds + H_KST + off_b(8 * fg + q_, 2 * m + (p_ >> 1)) + 8 * (p_ & 1)), lds_tr16(lds + H_KST + off_b(8 * fg + 4 + q_, 2 * m + (p_ >> 1)) + 8 * (p_ & 1)));
                        const f32x4 dv = *(const LAS f32x4*)(lds + H_D + (16 * m + 4 * fg) * 4);
                        S[m] = __builtin_amdgcn_mfma_f32_16x16x32_bf16(ka, vb, S[m] * dv, 0, 0, 0);
                    }
#pragma unroll
                    for (int blk = 0; blk < 2; ++blk) {
                        f16x4 w; w[0] = (f16)oi[blk][0]; w[1] = (f16)oi[blk][1]; w[2] = (f16)oi[blk][2]; w[3] = (f16)oi[blk][3];
                        *(f16x4*)(OH + rowbase + (size_t)(32 * c + 16 * blk + fr) * 512 + 16 * wave + 4 * fg) = w;
                    }
                }
                LDS_WAIT(); __syncthreads();
            }
            { float* sp = SSEG + ((size_t)unit * 128) * 128 + 16 * wave + fr;
#pragma unroll
              for (int m = 0; m < 8; ++m)
#pragma unroll
                  for (int r = 0; r < 4; ++r) sp[(size_t)(16 * m + 4 * fg + r) * 128] = S[m][r];
              if (tid < 128) LSEG[unit * 128 + tid] = ((LAS float*)(lds + H_GB))[tid]; }
            __syncthreads();
        }
        if (hi - lo > 1) xcd_barrier(bar);
        for (int unit = vcu; unit < 256; unit += G) {
            const int bh = unit >> 3, seg = unit & 7, b = bh >> 2, h = bh & 3;
            const size_t rowbase = (size_t)b * SEQ * 512 + (size_t)seg * 512 * 512 + h * 128;
            f32x4 S[8];
#pragma unroll
            for (int m = 0; m < 8; ++m) S[m] = (f32x4){0.f, 0.f, 0.f, 0.f};
            for (int j = 0; j < seg; ++j) {
                const float* sp = SSEG + ((size_t)(bh * 8 + j) * 128) * 128 + 16 * wave + fr; const float* lp = LSEG + (bh * 8 + j) * 128;
#pragma unroll
                for (int m = 0; m < 8; ++m) { const f32x4 lv = *(const f32x4*)(lp + 16 * m + 4 * fg);
#pragma unroll
                    for (int r = 0; r < 4; ++r) S[m][r] = S[m][r] * __expf(lv[r]) + sp[(size_t)(16 * m + 4 * fg + r) * 128]; }
            }
            bf16x8 sop[4];
#pragma unroll
            for (int ks = 0; ks < 4; ++ks) sop[ks] = pack_bf8(S[2 * ks], S[2 * ks + 1]);
            if (tid < 256) ((LAS float*)(lds + H_GB))[tid] = 0.f;
            f32x4 ga, gb; f16x8 qv;
            { const size_t ro = rowbase + (size_t)t * 512 + 8 * ch; ga = *(const f32x4*)(LOGF + ro); gb = *(const f32x4*)(LOGF + ro + 4); qv = *(const f16x8*)(QH + ro); }
            const f32x4 gn4 = *(const f32x4*)(args.in[16] + 16 * wave + 4 * fg);
            for (int c = 0; c < 16; ++c) {
                *(LAS f32x4*)(lds + H_GF + t * 512 + ch * 32) = ga; *(LAS f32x4*)(lds + H_GF + t * 512 + ch * 32 + 16) = gb;
                const f16x8 q8r = qv;
                if (c + 1 < 16) { const size_t ro = rowbase + (size_t)(32 * (c + 1) + t) * 512 + 8 * ch; ga = *(const f32x4*)(LOGF + ro); gb = *(const f32x4*)(LOGF + ro + 4); qv = *(const f16x8*)(QH + ro); }
                LDS_WAIT(); __syncthreads();
                HG_CUMSUM();
                LDS_WAIT(); __syncthreads();
                {
                    const LAS float* gfr = (const LAS float*)(lds + H_GF); const LAS float* tot = (const LAS float*)(lds + H_TOT);
                    const LAS float* gbc = (const LAS float*)(lds + H_GB) + (c & 1) * 128; LAS float* gbn = (LAS float*)(lds + H_GB) + ((c + 1) & 1) * 128;
                    f32x4 G0 = *(const LAS f32x4*)(gfr + t * 128 + 8 * ch), G1 = *(const LAS f32x4*)(gfr + t * 128 + 8 * ch + 4);
                    const f32x4 t0a = *(const LAS f32x4*)(tot + 8 * ch), t0b = *(const LAS f32x4*)(tot + 8 * ch + 4);
                    const f32x4 t1a = *(const LAS f32x4*)(tot + 128 + 8 * ch), t1b = *(const LAS f32x4*)(tot + 128 + 8 * ch + 4);
                    const f32x4 t2a = *(const LAS f32x4*)(tot + 256 + 8 * ch), t2b = *(const LAS f32x4*)(tot + 256 + 8 * ch + 4);
                    const int part = t >> 3;
                    if (part >= 1) { G0 += t0a; G1 += t0b; } if (part >= 2) { G0 += t1a; G1 += t1b; } if (part >= 3) { G0 += t2a; G1 += t2b; }
                    const f32x4 ba = *(const LAS f32x4*)(gbc + 8 * ch), bb = *(const LAS f32x4*)(gbc + 8 * ch + 4);
                    float qs[8];
#pragma unroll
                    for (int j = 0; j < 4; ++j) { qs[j] = (float)q8r[j] * __expf(G0[j] + ba[j]); qs[4 + j] = (float)q8r[4 + j] * __expf(G1[j] + bb[j]); }
                    HG_STORE(H_QS, t, qs);
                    if (t == 31) { *(LAS f32x4*)(gbn + 8 * ch) = G0 + ba; *(LAS f32x4*)(gbn + 8 * ch + 4) = G1 + bb; }
                }
                LDS_WAIT(); __syncthreads();
                f32x4 of[2];
#pragma unroll
                for (int blk = 0; blk < 2; ++blk) {
                    const f16x4 ol = *(const f16x4*)(OH + rowbase + (size_t)(32 * c + 16 * blk + fr) * 512 + 16 * wave + 4 * fg);
                    of[blk] = (f32x4){(float)ol[0], (float)ol[1], (float)ol[2], (float)ol[3]};
                }
                if (seg > 0) {
#pragma unroll
                    for (int ks = 0; ks < 4; ++ks)
#pragma unroll
                        for (int blk = 0; blk < 2; ++blk) {
                            const s16x4 qa = *(const LAS s16x4*)(lds + H_QS + off_b(16 * blk + fr, 4 * ks + (fg >> 1)) + 8 * (fg & 1));
                            const s16x4 qb = *(const LAS s16x4*)(lds + H_QS + off_b(16 * blk + fr, 4 * ks + 2 + (fg >> 1)) + 8 * (fg & 1));
                            of[blk] = __builtin_amdgcn_mfma_f32_16x16x32_bf16(sop[ks], cat44(qa, qb), of[blk], 0, 0, 0);
                        }
                }
#pragma unroll
                for (int blk = 0; blk < 2; ++blk) {
                    float ss = (of[blk][0] * of[blk][0] + of[blk][1] * of[blk][1]) + (of[blk][2] * of[blk][2] + of[blk][3] * of[blk][3]);
                    ss += __shfl_xor(ss, 16); ss += __shfl_xor(ss, 32);
                    if (fg == 0) ((LAS float*)(lds + H_SS))[wave * 32 + 16 * blk + fr] = ss;
                }
                LDS_WAIT(); __syncthreads();
#pragma unroll
                for (int blk = 0; blk < 2; ++blk) {
                    float tot2 = 0.f;
#pragma unroll
                    for (int w8 = 0; w8 < 8; ++w8) tot2 += ((const LAS float*)(lds + H_SS))[w8 * 32 + 16 * blk + fr];
                    const float rstd = __builtin_amdgcn_rsqf(tot2 * (1.f / 128.f) + EPS);
                    const size_t oo = rowbase + (size_t)(32 * c + 16 * blk + fr) * 512 + 16 * wave + 4 * fg;
                    const f16x4 gh4 = *(const f16x4*)(GH + oo);
                    f16x4 w;
#pragma unroll
                    for (int r = 0; r < 4; ++r) w[r] = (f16)(of[blk][r] * rstd * gn4[r] * (float)gh4[r]);
                    *(f16x4*)(YB + oo) = w;
                }
            }
            __syncthreads();
        }
#undef HG_CUMSUM
#undef HG_STORE
    }
    SEAM(6);
    if (IN(7)) for (int rep_ = 0; rep_ < REPS(7); ++rep_) { PH_BEGIN();
        LAS float* relb = (LAS float*)(lds + TAB_OFF); LAS int* bkt = (LAS int*)(lds + TAB_OFF + 2048);
        relb[tid] = ((tid & 15) < 8) ? args.in[2][(tid >> 4) * 8 + (tid & 15)] : 0.f;
        if (tid < 128) { int bk = tid; if (tid >= 16) { const float vv = __logf((float)tid / 16.f) / 2.0794415416798357f * 16.f; bk = 16 + (int)vv; bk = bk > 31 ? 31 : bk; } bkt[tid] = bk; }
        __syncthreads();
        LAS unsigned char* const cbuf = lds + wave * 16384;
        LAS unsigned* const lst = (LAS unsigned*)(lds + WSM_OFF + wave * WSM_BYTES);
        unsigned* const SCR = (unsigned*)(ws + WS_QH) + (size_t)bx * (16 * 4096);
        constexpr unsigned KMIN = 0x007FFFFFu;
        for (int un = bx; un < 2048; un += G) {
            const int b = un & 7, idx = un >> 3, jj_ = idx & 31, kk_ = idx >> 5; const int qt = (kk_ & 1) ? 32 * kk_ + 31 - jj_ : 32 * kk_ + jj_;
            const int q0 = b * SEQ + 16 * qt;
            {
                const int fr = lane & 15, fq = lane >> 4;
                f16x8 Qf[8][2];
                const f16* qp = QIDX + (size_t)(q0 + fr) * 512 + 8 * fq;
#pragma unroll
                for (int h = 0; h < 8; ++h) { Qf[h][0] = *(const f16x8*)(qp + h * 64); Qf[h][1] = *(const f16x8*)(qp + h * 64 + 32); }
                const f32x4 w0 = *(const f32x4*)(WQ + (size_t)(q0 + fr) * 8), w1 = *(const f32x4*)(WQ + (size_t)(q0 + fr) * 8 + 4);
                const int nkt = qt + 1;
                for (int kt = wave; kt < nkt; kt += 8) {
                    const f16* kp = KIDX + ((size_t)b * SEQ + 16 * kt + fr) * 64 + 8 * fq;
                    const f16x8 A0 = *(const f16x8*)kp, A1 = *(const f16x8*)(kp + 32);
                    f32x4 sc4 = {0.f, 0.f, 0.f, 0.f};
#pragma unroll
                    for (int h = 0; h < 8; ++h) {
                        f32x4 d = __builtin_amdgcn_mfma_f32_16x16x32_f16(A0, Qf[h][0], (f32x4){0.f, 0.f, 0.f, 0.f}, 0, 0, 0);
                        d = __builtin_amdgcn_mfma_f32_16x16x32_f16(A1, Qf[h][1], d, 0, 0, 0);
                        const float wh = h < 4 ? w0[h] : w1[h - 4];
#pragma unroll
                        for (int r = 0; r < 4; ++r) sc4[r] += wh * fmaxf(d[r], 0.f);
                    }
                    u32x4 o;
#pragma unroll
                    for (int r = 0; r < 4; ++r) { const unsigned x = __float_as_uint(sc4[r]); o[r] = (x & 0x80000000u) ? ~x : (x | 0x80000000u); }
                    *(u32x4*)(SCR + fr * 4096 + 16 * kt + 4 * fq) = o;
                }
            }
            VM_WAIT(); __syncthreads();
            for (int qi = 2 * wave; qi < 2 * wave + 2; ++qi) {
                const int q = q0 + qi, t = 16 * qt + qi;
                const unsigned* sp = SCR + qi * 4096;
                unsigned uk[64];
#pragma unroll
                for (int j = 0; j < 16; ++j) {
                    u32x4 v = {KMIN, KMIN, KMIN, KMIN};
                    if (256 * j <= t) v = *(const u32x4*)(sp + 256 * j + 4 * lane);
#pragma unroll
                    for (int e = 0; e < 4; ++e) uk[4 * j + e] = (256 * j + 4 * lane + e <= t) ? v[e] : KMIN;
                }
                unsigned Tk = KMIN; int r = 0;
                if (t + 1 > 256) {
                    unsigned lo_ = 0x00800000u, hi_ = 0xFFFFFFFFu;
                    while (lo_ < hi_) {
                        const unsigned mid = lo_ + ((hi_ - lo_) >> 1) + 1u; int c;
                        { unsigned s0_ = 0u, s1_ = 0u, s2_ = 0u, s3_ = 0u; const int th_ = (int)(mid ^ 0x80000000u);
#pragma unroll
                          for (int i = 0; i < 16; ++i) { s0_ = __builtin_amdgcn_alignbit(s0_, (unsigned)__builtin_elementwise_sub_sat((int)(uk[i] ^ 0x80000000u), th_), 31); s1_ = __builtin_amdgcn_alignbit(s1_, (unsigned)__builtin_elementwise_sub_sat((int)(uk[16 + i] ^ 0x80000000u), th_), 31);
                              s2_ = __builtin_amdgcn_alignbit(s2_, (unsigned)__builtin_elementwise_sub_sat((int)(uk[32 + i] ^ 0x80000000u), th_), 31); s3_ = __builtin_amdgcn_alignbit(s3_, (unsigned)__builtin_elementwise_sub_sat((int)(uk[48 + i] ^ 0x80000000u), th_), 31); }
                          c = 4096 - wave_total_i(__popc(s0_) + __popc(s1_) + __popc(s2_) + __popc(s3_)); }
                        if (c == 256) { lo_ = mid - 1u; hi_ = mid - 1u; break; }
                        if (c > 256) lo_ = mid; else hi_ = mid - 1u;
                    }
                    Tk = lo_; int cg = 0;
#pragma unroll
                    for (int i = 0; i < 64; ++i) { cg += __popcll(__ballot(uk[i] > Tk)); if ((i & 3) == 3) asm volatile("" : "+s"(cg)); }
                    r = 256 - cg;
                }
                int nb = 0, eb = 0;
#pragma unroll
                for (int j = 0; j < 16; ++j) {
                    if (256 * j <= t) {
                        bool gt[4], eq[4], sel[4]; int leq = 0, teq = 0;
#pragma unroll
                        for (int e = 0; e < 4; ++e) { gt[e] = uk[4 * j + e] > Tk; eq[e] = uk[4 * j + e] == Tk; const unsigned long long me = __ballot(eq[e]);
                            leq += (int)__builtin_amdgcn_mbcnt_hi((unsigned)(me >> 32), __builtin_amdgcn_mbcnt_lo((unsigned)me, 0u)); teq += __popcll(me); }
                        int run = eb + leq, lsel = 0, tsel = 0;
#pragma unroll
                        for (int e = 0; e < 4; ++e) { sel[e] = gt[e] || (eq[e] && run < r); run += eq[e] ? 1 : 0; const unsigned long long ms = __ballot(sel[e]);
                            lsel += (int)__builtin_amdgcn_mbcnt_hi((unsigned)(ms >> 32), __builtin_amdgcn_mbcnt_lo((unsigned)ms, 0u)); tsel += __popcll(ms); }
                        int pos = nb + lsel;
#pragma unroll
                        for (int e = 0; e < 4; ++e) { if (sel[e]) { const int sk = 256 * j + 4 * lane + e; int dd = t - sk; dd = dd > 127 ? 127 : dd; lst[pos] = (unsigned)sk | ((unsigned)bkt[dd] << 16); ++pos; } }
                        nb += tsel; eb += teq;
                        asm volatile("" : "+s"(nb), "+s"(eb));
                    }
                }
                LDS_WAIT();
                const int nsel = nb;
                const int nch = (nsel + 31) >> 5;
                if (lane < nch * 32 - nsel) lst[nsel + lane] = 0u;
                LDS_WAIT();
                const int fr = lane & 15, fg = lane >> 4, q_ = fr >> 2, p_ = fr & 3;
                f16x8 qB[4];
#pragma unroll
                for (int ks = 0; ks < 4; ++ks) { qB[ks] = (f16x8){0, 0, 0, 0, 0, 0, 0, 0}; if (fr < 8) qB[ks] = *(const f16x8*)(QLAT + (size_t)q * 1024 + fr * 128 + 32 * ks + 8 * fg); }
                const f16* cbase = CKV + (size_t)b * SEQ * 128;
#define AT_GATHER(ci) do { LAS unsigned char* dst_ = cbuf + ((ci) & 1) * 8192; _Pragma("unroll") for (int i_ = 0; i_ < 8; ++i_) { \
                    const unsigned en_ = lst[(ci) * 32 + 4 * i_ + fg]; const unsigned sw_ = (unsigned)((fg << 2) | (i_ & 3)); \
                    __builtin_amdgcn_global_load_lds((const unsigned*)(cbase + (size_t)(en_ & 0xFFFFu) * 128 + 8 * (fr ^ sw_)), (LAS unsigned*)(dst_ + i_ * 1024), 16, 0, 0); } } while (0)
                AT_GATHER(0);
                f32x4 O[8];
#pragma unroll
                for (int c = 0; c < 8; ++c) O[c] = (f32x4){0.f, 0.f, 0.f, 0.f};
                float m_run = -__builtin_inff(), l_run = 0.f;
                for (int ci = 0; ci < nch; ++ci) {
                    LDS_WAIT();
                    if (ci + 1 < nch) { AT_GATHER(ci + 1); asm volatile("s_waitcnt vmcnt(8)" ::: "memory"); } else { asm volatile("s_waitcnt vmcnt(0)" ::: "memory"); }
                    const LAS unsigned char* buf = cbuf + (ci & 1) * 8192;
                    f32x4 d0 = {0.f, 0.f, 0.f, 0.f}, d1 = d0;
#pragma unroll
                    for (int ks = 0; ks < 4; ++ks) {
                        const f16x8 a0 = *(const LAS f16x8*)(buf + off_b(8 * q_ + p_, 4 * ks + fg)), a1 = *(const LAS f16x8*)(buf + off_b(8 * q_ + 4 + p_, 4 * ks + fg));
                        d0 = __builtin_amdgcn_mfma_f32_16x16x32_f16(a0, qB[ks], d0, 0, 0, 0);
                        d1 = __builtin_amdgcn_mfma_f32_16x16x32_f16(a1, qB[ks], d1, 0, 0, 0);
                    }
                    const u32x4 e0 = *(const LAS u32x4*)(lst + ci * 32 + 8 * fg), e1 = *(const LAS u32x4*)(lst + ci * 32 + 8 * fg + 4);
                    float lg[8];
#pragma unroll
                    for (int r = 0; r < 4; ++r) {
                        lg[r] = (ci * 32 + 8 * fg + r < nsel) ? d0[r] * 0.125f + relb[(e0[r] >> 16) * 16 + fr] : -__builtin_inff();
                        lg[4 + r] = (ci * 32 + 8 * fg + 4 + r < nsel) ? d1[r] * 0.125f + relb[(e1[r] >> 16) * 16 + fr] : -__builtin_inff();
                    }
                    float mx = fmaxf(fmaxf(fmaxf(lg[0], lg[1]), fmaxf(lg[2], lg[3])), fmaxf(fmaxf(lg[4], lg[5]), fmaxf(lg[6], lg[7])));
                    mx = fmaxf(mx, __shfl_xor(mx, 16)); mx = fmaxf(mx, __shfl_xor(mx, 32));
                    const float m_new = fmaxf(m_run, mx);
                    const float alpha = __expf(m_run - m_new);
                    m_run = m_new;
                    float pr[8], ps = 0.f;
#pragma unroll
                    for (int r = 0; r < 8; ++r) { pr[r] = __expf(lg[r] - m_new); ps += pr[r]; }
                    l_run = l_run * alpha + ps;
                    f16x8 pa;
#pragma unroll
                    for (int r = 0; r < 8; ++r) pa[r] = (f16)pr[r];
                    float al[4];
#pragma unroll
                    for (int r = 0; r < 4; ++r) al[r] = __shfl(alpha, 4 * fg + r);
#pragma unroll
                    for (int c = 0; c < 8; ++c) {
#pragma unroll
                        for (int r = 0; r < 4; ++r) O[c][r] *= al[r];
                        const s16x4 t0 = lds_tr16(buf + off_b(8 * fg + q_, 2 * c + (p_ >> 1)) + 8 * (p_ & 1)), t1 = lds_tr16(buf + off_b(8 * fg + 4 + q_, 2 * c + (p_ >> 1)) + 8 * (p_ & 1));
                        O[c] = __builtin_amdgcn_mfma_f32_16x16x32_f16(pa, __builtin_bit_cast(f16x8, cat44(t0, t1)), O[c], 0, 0, 0);
                    }
                }
#undef AT_GATHER
                float lt = l_run; lt += __shfl_xor(lt, 16); lt += __shfl_xor(lt, 32);
                const float inv = 1.0f / lt;
                float iv[4];
#pragma unroll
                for (int r = 0; r < 4; ++r) iv[r] = __shfl(inv, 4 * fg + r);
                if (fg < 2) {
#pragma unroll
                    for (int c = 0; c < 8; ++c)
#pragma unroll
                        for (int r = 0; r < 4; ++r) QLAT[(size_t)q * 1024 + (4 * fg + r) * 128 + 16 * c + fr] = (f16)(O[c][r] * iv[r]);
                }
                LDS_WAIT();
            }
            __syncthreads();
        }
    }
    SEAM(7);
    if (IN(8)) for (int rep_ = 0; rep_ < REPS(8); ++rep_) { PH_BEGIN(); pg8::Gemm g{XN, (const f16*)(ws + W_G), M, NGATE, DM}; pg8::StaticOrder S; S.init(M, NGATE, G, bx);
        pg8::Epi<pg8::EP_GATES> E{}; E.O = GT; E.ldc = NGATE; E.bias = args.in[19]; pg8::gemm_phase(lds, g, S, E); }
    SEAM(8);
    if (IN(9)) for (int rep_ = 0; rep_ < REPS(9); ++rep_) { PH_BEGIN(); pg8::Gemm g{QLAT, (const f16*)(ws + W_UVBR), M, DM, DM}; pg8::StaticOrder S; S.init(M, DM, G, bx);
        pg8::Epi<pg8::EP_BRA> E{}; E.O = MERGED; E.ldc = DM; E.Gt = GT; pg8::gemm_phase(lds, g, S, E); }
    if (IN(10)) for (int rep_ = 0; rep_ < REPS(10); ++rep_) { PH_BEGIN(); pg8::Gemm g{YB, (const f16*)(ws + W_BRB), M, DM, 512}; pg8::StaticOrder S; S.init(M, DM, G, bx);
        pg8::Epi<pg8::EP_BRB> E{}; E.O = MERGED; E.ldc = DM; E.Gt = GT; pg8::gemm_phase(lds, g, S, E); }
    SEAM(10);
    if (IN(11)) for (int rep_ = 0; rep_ < REPS(11); ++rep_) { PH_BEGIN(); pg8::Gemm g{MERGED, (const f16*)(ws + W_OUT), M, DM, DM}; pg8::StaticOrder S; S.init(M, DM, G, bx);
        pg8::Epi<pg8::EP_F16> E{}; E.O = Y; E.ldc = DM; pg8::gemm_phase(lds, g, S, E); }
    SEAM(11);
    if (IN(12)) for (int rep_ = 0; rep_ < REPS(12); ++rep_) { PH_BEGIN(); for (int m = 2 * gw; m < M; m += 2 * NGW) row_update2<true, true>((f16*)HOUT + (size_t)m * 2048 + 1024, 2048, Y + (size_t)m * DM, args.in[10], 1.0f, (f16*)HOUT + (size_t)m * 2048 + 1024, 2048, args.in[21], XN + (size_t)m * DM, lane); }
    SEAM(12);
    if (IN(13)) for (int rep_ = 0; rep_ < REPS(13); ++rep_) { PH_BEGIN(); pg8::Gemm g{XN, (const f16*)(ws + W_GU2), M, 2 * FF, DM}; pg8::StaticOrder S; S.init(M, 2 * FF, G, bx);
        pg8::Epi<pg8::EP_SWIGLU> E{}; E.O = ACT; E.ldc = FF; pg8::gemm_phase(lds, g, S, E); }
    SEAM(13);
    if (IN(14)) for (int rep_ = 0; rep_ < REPS(14); ++rep_) { PH_BEGIN(); pg8::Gemm g{ACT, (const f16*)(ws + W_D2), M, DM, FF}; pg8::StaticOrder S; S.init(M, DM, G, bx);
        pg8::Epi<pg8::EP_F16> E{}; E.O = Y; E.ldc = DM; pg8::gemm_phase(lds, g, S, E); }
    SEAM(14);
    if (IN(15)) for (int rep_ = 0; rep_ < REPS(15); ++rep_) { PH_BEGIN(); for (int m = 2 * gw; m < M; m += 2 * NGW) row_update2<true, true>((f16*)HOUT + (size_t)m * 2048 + 1024, 2048, Y + (size_t)m * DM, args.in[22], 0.5f, (f16*)HOUT + (size_t)m * 2048 + 1024, 2048, args.in[26], XN + (size_t)m * DM, lane); }
    SEAM(15);
    if (IN(16)) for (int rep_ = 0; rep_ < REPS(16); ++rep_) { PH_BEGIN(); pg8::Gemm g{XN, (const f16*)(ws + W_PG), M, DM, DM}; pg8::StaticOrder S; S.init(M, DM, G, bx);
        pg8::Epi<pg8::EP_PLE1> E{}; E.O = GP; E.ldc = DM; pg8::gemm_phase(lds, g, S, E); }
    if (IN(17)) for (int rep_ = 0; rep_ < REPS(17); ++rep_) { PH_BEGIN(); pg8::Gemm g{P16, (const f16*)(ws + W_PP), M, DM, PLE}; pg8::StaticOrder S; S.init(M, DM, G, bx);
        pg8::Epi<pg8::EP_PLE2> E{}; E.O = Y; E.ldc = DM; E.Gt = GP; pg8::gemm_phase(lds, g, S, E); }
    SEAM(17);
    if (IN(18)) for (int rep_ = 0; rep_ < REPS(18); ++rep_) { PH_BEGIN(); for (int m = 2 * gw; m < M; m += 2 * NGW) row_update2<true, false>((f16*)HOUT + (size_t)m * 2048 + 1024, 2048, Y + (size_t)m * DM, args.in[27], 1.0f, HOUT + (size_t)m * DM, DM, nullptr, nullptr, lane); }
#undef IN
#undef SEAM
#undef PH_BEGIN
}

extern "C" void kernel_launch(void* const* d_in, const int* in_sizes, int n_in, void* d_out, int out_size, void* d_ws, size_t ws_size, hipStream_t stream) {
    static int grid = 0;
    if (grid == 0) {
        if (n_in != 30 || in_sizes[0] != M * DM || out_size != M * DM || ws_size < WS_END) {
            fprintf(stderr, "kernel_launch: unexpected shapes/workspace (n_in %d, in0 %d, out %d, ws %zu)\n", n_in, n_in > 0 ? in_sizes[0] : -1, out_size, ws_size); grid = -1; return; }
        int dev = 0, cus = 0;
        if (hipGetDevice(&dev) != hipSuccess || hipDeviceGetAttribute(&cus, hipDeviceAttributeMultiprocessorCount, dev) != hipSuccess) { grid = -1; return; }
        if (hipFuncSetAttribute((const void*)mk_fwd, hipFuncAttributeMaxDynamicSharedMemorySize, LDS_BYTES) != hipSuccess) { fprintf(stderr, "kernel_launch: hipFuncSetAttribute failed\n"); grid = -1; return; }
        (void)hipGetLastError();
        grid = cus;
    }
    if (grid < 0) return;
    (void)hipMemsetAsync((char*)d_ws + WS_CTL, 0, CTL_ZERO_BYTES, stream);
    Args a{};
    for (int i = 0; i < 30; ++i) a.in[i] = (const float*)d_in[i];
    a.out = (float*)d_out; a.ws = (unsigned char*)d_ws;
#if MK_PER_PHASE_LAUNCH
    for (int ph = 0; ph < NPHASE; ++ph) { a.ph_lo = ph; a.ph_hi = ph + 1; hipLaunchKernelGGL(mk_fwd, dim3(grid), dim3(NTHREADS), LDS_BYTES, stream, a); }
#else
    a.ph_lo = 0; a.ph_hi = NPHASE; hipLaunchKernelGGL(mk_fwd, dim3(grid), dim3(NTHREADS), LDS_BYTES, stream, a);
#endif
}
```
